# Optimizing an MI355X kernel written in HIP

```python
import math
import jax
import jax.numpy as jnp
from jax import lax
import numpy as np

D_MODEL = 2048
BATCH = 2
SEQ = 8192
DEPTH = 1

D_ATTN = D_MODEL // 2
HEAD_DIM_A = 64
N_HEADS_A = D_ATTN // HEAD_DIM_A
DILATED_CONFIGS = ((128, 1), (512, 4), (2048, 16))
ATTN_BLOCK = 128
NUM_BUCKETS = 32
MAX_DISTANCE = 2048
D_MLSTM = D_MODEL - D_ATTN
N_HEADS_M = 4
HEAD_DIM_M = D_MLSTM // N_HEADS_M
CONV_K = 4
MLSTM_CHUNK = 128
IN_COLS = 3 * D_ATTN + 4 * D_MLSTM + 2 * N_HEADS_M
SPLITS = (D_ATTN, 2 * D_ATTN, 3 * D_ATTN, 3 * D_ATTN + 2 * D_MLSTM, 3 * D_ATTN + 3 * D_MLSTM,
          3 * D_ATTN + 4 * D_MLSTM, 3 * D_ATTN + 4 * D_MLSTM + N_HEADS_M)
N_EXPERTS = 32
TOP_K = 4
D_FF = D_MODEL
SWIGLU_LIMIT = 7.0
SWIGLU_ALPHA = 1.702
EXPERT_BLOCK = 128
DN_ALPHA = (2 * DEPTH) ** 0.25
DN_BETA = (8 * DEPTH) ** -0.25
LN_EPS = 1e-5
HEAD_NORM_EPS = 1e-6
NEG_INF = -1e30

kernel_name = "hymba_dilated_mlstm_moe_deepnorm"


def layer_norm(x, g, b):
    xf = x.astype(jnp.float32)
    mu = jnp.mean(xf, axis=-1, keepdims=True)
    var = jnp.mean(jnp.square(xf - mu), axis=-1, keepdims=True)
    return ((xf - mu) * lax.rsqrt(var + LN_EPS) * g + b).astype(x.dtype)


def head_rms(t):
    tf = t.astype(jnp.float32)
    tf = tf * lax.rsqrt(jnp.mean(jnp.square(tf), axis=-1, keepdims=True) + HEAD_NORM_EPS)
    return tf.reshape(t.shape[0], t.shape[1], -1)


def t5_bucket(dist):
    max_exact = NUM_BUCKETS // 2
    d_f = jnp.maximum(dist, 1).astype(jnp.float32)
    large = max_exact + (jnp.log(d_f / max_exact) / math.log(MAX_DISTANCE / max_exact)
                         * (NUM_BUCKETS - max_exact)).astype(jnp.int32)
    large = jnp.minimum(large, NUM_BUCKETS - 1)
    return jnp.where(dist < max_exact, dist, large)


def dilated_branch(q, k, v, rel_bias, window, dil):
    B, H, S, dh = q.shape
    n_back = window // dil
    L = S // dil
    Lp = -(-L // ATTN_BLOCK) * ATTN_BLOCK
    nb = Lp // ATTN_BLOCK

    def to_blocks(t):
        t = t.reshape(B, H, L, dil, dh).transpose(0, 1, 3, 2, 4)
        t = jnp.pad(t, ((0, 0), (0, 0), (0, 0), (0, Lp - L), (0, 0)))
        return t.reshape(B, H, dil, nb, ATTN_BLOCK, dh)

    def with_prev(t):
        prev = jnp.concatenate([jnp.zeros_like(t[:, :, :, :1]), t[:, :, :, :-1]], axis=3)
        return jnp.concatenate([prev, t], axis=4)

    qb = to_blocks(q)
    kc = with_prev(to_blocks(k))
    vc = with_prev(to_blocks(v)).astype(jnp.float32)
    s = jnp.einsum('bhrnqc,bhrnkc->bhrnqk', qb, kc).astype(jnp.float32)

    j = (jnp.arange(ATTN_BLOCK)[:, None] + ATTN_BLOCK) - jnp.arange(2 * ATTN_BLOCK)[None, :]
    band = (j >= 0) & (j <= n_back)
    has_prev = (jnp.arange(nb)[:, None, None] > 0) | (jnp.arange(2 * ATTN_BLOCK)[None, None, :] >= ATTN_BLOCK)
    mask = band[None] & has_prev
    bias = rel_bias[t5_bucket(jnp.maximum(j, 0) * dil)].transpose(2, 0, 1)
    s = s + bias[None, :, None, None].astype(jnp.float32)
    s = jnp.where(mask, s, NEG_INF)

    m = jnp.max(s, axis=-1, keepdims=True)
    p = jnp.exp(s - m)
    den = jnp.sum(p, axis=-1, keepdims=True)
    o = jnp.einsum('bhrnqk,bhrnkc->bhrnqc', p, vc) / den
    lse = (m + jnp.log(den))[..., 0]

    o = o.reshape(B, H, dil, Lp, dh)[:, :, :, :L].transpose(0, 1, 3, 2, 4).reshape(B, H, S, dh)
    lse = lse.reshape(B, H, dil, Lp)[:, :, :, :L].transpose(0, 1, 3, 2).reshape(B, H, S)
    return o, lse


def causal_depthwise_conv(t, w, b):
    C = t.shape[-1]
    out = lax.conv_general_dilated(t, w[:, None, :].astype(t.dtype), window_strides=(1,),
                                   padding=[(CONV_K - 1, 0)], dimension_numbers=('NWC', 'WIO', 'NWC'),
                                   feature_group_count=C)
    return out + b


def mlstm(q, k, v, i_pre, f_pre):
    B, S, H, dh = q.shape
    N = S // MLSTM_CHUNK
    f32 = jnp.float32

    def chunks(t):
        return t.astype(f32).reshape(B, N, MLSTM_CHUNK, H, dh).transpose(1, 0, 3, 2, 4)

    def gchunks(t):
        return t.astype(f32).reshape(B, N, MLSTM_CHUNK, H).transpose(1, 0, 3, 2)

    qc, kc, vc = chunks(q), chunks(k) * (dh ** -0.5), chunks(v)
    ic = gchunks(i_pre)
    lfc = jax.nn.log_sigmoid(gchunks(f_pre))
    causal = jnp.tril(jnp.ones((MLSTM_CHUNK, MLSTM_CHUNK), dtype=bool))

    def step(carry, inp):
        C, n, m = carry
        qt, kt, vt, it, lf = inp
        b = jnp.cumsum(lf, axis=-1)
        D = jnp.where(causal, b[..., :, None] - b[..., None, :] + it[..., None, :], -jnp.inf)
        m_inter = b + m[..., None]
        m_t = jnp.maximum(m_inter, jnp.max(D, axis=-1))
        W = jnp.exp(D - m_t[..., None]) * jnp.einsum('bhtd,bhsd->bhts', qt, kt)
        decay = jnp.exp(m_inter - m_t)
        num = jnp.einsum('bhts,bhsd->bhtd', W, vt) + decay[..., None] * jnp.einsum('bhvk,bhtk->bhtv', C, qt)
        den = jnp.sum(W, axis=-1) + decay * jnp.einsum('bhk,bhtk->bht', n, qt)
        h = num / jnp.maximum(jnp.abs(den), jnp.exp(-m_t))[..., None]
        g = b[..., -1]
        a = g[..., None] - b + it
        m_new = jnp.maximum(g + m, jnp.max(a, axis=-1))
        carry_decay = jnp.exp(g + m - m_new)
        wa = jnp.exp(a - m_new[..., None])
        C = carry_decay[..., None, None] * C + jnp.einsum('bhsv,bhsk->bhvk', wa[..., None] * vt, kt)
        n = carry_decay[..., None] * n + jnp.einsum('bhs,bhsk->bhk', wa, kt)
        return (C, n, m_new), h

    init = (jnp.zeros((B, H, dh, dh), f32), jnp.zeros((B, H, dh), f32), jnp.zeros((B, H), f32))
    _, hs = lax.scan(step, init, (qc, kc, vc, ic, lfc))
    return hs.transpose(1, 0, 3, 2, 4).reshape(B, S, H, dh)


def hybrid_mixer(h, w_in, b_igate, b_fgate, conv_w, conv_b, rel_bias, beta_attn, beta_mlstm, w_out):
    B, S, _ = h.shape
    proj = h @ w_in
    qa, ka, va, qk_m, vm, om, ig, fg = jnp.split(proj, SPLITS, axis=-1)

    def heads_a(t):
        return t.reshape(B, S, N_HEADS_A, HEAD_DIM_A).transpose(0, 2, 1, 3)
    qa = heads_a(qa) * (HEAD_DIM_A ** -0.5)
    ka, va = heads_a(ka), heads_a(va)
    outs, lses = [], []
    for window, dil in DILATED_CONFIGS:
        o, l = dilated_branch(qa, ka, va, rel_bias, window, dil)
        outs.append(o)
        lses.append(l)
    wts = jax.nn.softmax(jnp.stack(lses), axis=0)
    o_attn = jnp.einsum('gbhs,gbhsd->bshd', wts, jnp.stack(outs))

    qk_m = jax.nn.silu(causal_depthwise_conv(qk_m, conv_w, conv_b))
    qm, km = jnp.split(qk_m, 2, axis=-1)
    def heads_m(t):
        return t.reshape(B, S, N_HEADS_M, HEAD_DIM_M)
    hm = mlstm(heads_m(qm), heads_m(km), heads_m(vm), ig + b_igate, fg + b_fgate)
    hm = jax.nn.sigmoid(heads_m(om).astype(jnp.float32)) * hm

    y = jnp.concatenate([head_rms(o_attn) * beta_attn, head_rms(hm) * beta_mlstm], axis=-1)
    return y.astype(h.dtype) @ w_out


def moe_ffn(xf, w_router, b_router, w_up, b_up, w_down, b_down):
    N, D = xf.shape
    logits = (xf @ w_router + b_router).astype(jnp.float32)
    top_vals, top_idx = lax.top_k(logits, TOP_K)
    gates = jax.nn.softmax(top_vals, axis=-1)
    A = N * TOP_K
    e_flat = top_idx.reshape(-1).astype(jnp.int32)
    tok_flat = jnp.arange(A, dtype=jnp.int32) // TOP_K
    g_flat = gates.reshape(-1)

    order = jnp.argsort(e_flat, stable=True)
    e_sorted = e_flat[order]
    counts = jnp.zeros((N_EXPERTS,), jnp.int32).at[e_flat].add(1)
    padded = (counts + EXPERT_BLOCK - 1) // EXPERT_BLOCK * EXPERT_BLOCK
    pad_end = jnp.cumsum(padded)
    pad_start = pad_end - padded
    start = jnp.cumsum(counts) - counts
    dest = pad_start[e_sorted] + (jnp.arange(A, dtype=jnp.int32) - start[e_sorted])
    n_blocks = -(-A // EXPERT_BLOCK) + N_EXPERTS
    P = n_blocks * EXPERT_BLOCK
    slot_tok = jnp.zeros((P,), jnp.int32).at[dest].set(tok_flat[order])
    slot_gate = jnp.zeros((P,), jnp.float32).at[dest].set(g_flat[order])
    blk_exp = jnp.minimum(jnp.searchsorted(pad_end, jnp.arange(n_blocks, dtype=jnp.int32) * EXPERT_BLOCK,
                                           side='right'), N_EXPERTS - 1).astype(jnp.int32)
    xs = xf[slot_tok].reshape(n_blocks, EXPERT_BLOCK, D)

    def expert_block(args):
        e, xb = args
        hg = xb @ w_up[e] + b_up[e]
        gate = jnp.minimum(hg[:, :D_FF], SWIGLU_LIMIT)
        up = jnp.clip(hg[:, D_FF:], -SWIGLU_LIMIT, SWIGLU_LIMIT)
        act = (up + 1.0) * (gate * jax.nn.sigmoid(SWIGLU_ALPHA * gate))
        return act @ w_down[e] + b_down[e]

    ys = lax.map(expert_block, (blk_exp, xs)).reshape(P, D)
    return jnp.zeros_like(xf).at[slot_tok].add(ys * slot_gate[:, None].astype(ys.dtype))


def setup_inputs(seed: int = 0) -> dict:
    key = jax.random.key(seed)
    ks = jax.random.split(key, 20)
    f32 = jnp.float32
    nrm = lambda k, shape: jax.random.normal(k, shape, f32)
    return {
        "x": nrm(ks[0], (BATCH, SEQ, D_MODEL)),
        "w_in": nrm(ks[1], (DEPTH, D_MODEL, IN_COLS)) * D_MODEL ** -0.5,
        "b_igate": 0.1 * nrm(ks[2], (DEPTH, N_HEADS_M)),
        "b_fgate": jnp.linspace(3.0, 6.0, N_HEADS_M, dtype=f32)[None] + 0.1 * nrm(ks[3], (DEPTH, N_HEADS_M)),
        "conv_w": nrm(ks[4], (DEPTH, CONV_K, 2 * D_MLSTM)) * CONV_K ** -0.5,
        "conv_b": 0.01 * nrm(ks[5], (DEPTH, 2 * D_MLSTM)),
        "rel_bias": 0.5 * nrm(ks[6], (NUM_BUCKETS, N_HEADS_A)),
        "beta_attn": 1.0 + 0.02 * nrm(ks[7], (DEPTH, D_ATTN)),
        "beta_mlstm": 1.0 + 0.02 * nrm(ks[8], (DEPTH, D_MLSTM)),
        "w_out": nrm(ks[9], (DEPTH, D_MODEL, D_MODEL)) * (D_MODEL ** -0.5 * DN_BETA),
        "ln1_g": 1.0 + 0.02 * nrm(ks[10], (DEPTH, D_MODEL)),
        "ln1_b": 0.02 * nrm(ks[11], (DEPTH, D_MODEL)),
        "w_router": nrm(ks[12], (DEPTH, D_MODEL, N_EXPERTS)) * D_MODEL ** -0.5,
        "b_router": 0.01 * nrm(ks[13], (DEPTH, N_EXPERTS)),
        "w_up": nrm(ks[14], (DEPTH, N_EXPERTS, D_MODEL, 2 * D_FF)) * D_MODEL ** -0.5,
        "b_up": 0.01 * nrm(ks[15], (DEPTH, N_EXPERTS, 2 * D_FF)),
        "w_down": nrm(ks[16], (DEPTH, N_EXPERTS, D_FF, D_MODEL)) * (D_FF ** -0.5 * DN_BETA),
        "b_down": 0.01 * nrm(ks[17], (DEPTH, N_EXPERTS, D_MODEL)),
        "ln2_g": 1.0 + 0.02 * nrm(ks[18], (DEPTH, D_MODEL)),
        "ln2_b": 0.02 * nrm(ks[19], (DEPTH, D_MODEL)),
    }


def reference(x, w_in, b_igate, b_fgate, conv_w, conv_b, rel_bias, beta_attn, beta_mlstm, w_out,
              ln1_g, ln1_b, w_router, b_router, w_up, b_up, w_down, b_down, ln2_g, ln2_b):
    h = x
    B, S, D = h.shape
    for l in range(DEPTH):
        mix = hybrid_mixer(h, w_in[l], b_igate[l], b_fgate[l], conv_w[l], conv_b[l], rel_bias,
                           beta_attn[l], beta_mlstm[l], w_out[l])
        h = layer_norm(DN_ALPHA * h + mix, ln1_g[l], ln1_b[l])
        ffn = moe_ffn(h.reshape(B * S, D), w_router[l], b_router[l], w_up[l], b_up[l],
                      w_down[l], b_down[l]).reshape(B, S, D)
        h = layer_norm(DN_ALPHA * h + ffn, ln2_g[l], ln2_b[l])
    return h
```

```cpp
#include <hip/hip_runtime.h>
#include <cstdio>
#include <cstdint>

#define LDP_PAD 128
#ifndef REP_MASK
#define REP_MASK 0
#endif
#ifndef MK_ONE_LAUNCH
#define MK_ONE_LAUNCH 1
#endif

namespace pg8 {
#define PG8_LAS __attribute__((address_space(3)))
typedef unsigned short bf16_t;
typedef short bf16x8 __attribute__((ext_vector_type(8)));
typedef float f32x4 __attribute__((ext_vector_type(4)));
typedef float f32x2 __attribute__((ext_vector_type(2)));
typedef unsigned u32x4 __attribute__((ext_vector_type(4)));
constexpr int BM = 256, BK = 64, HALF = 128, HTB = HALF * BK * 2, STAGE_BYTES = 8 * HTB, NXCD = 8, WGM = 8;

__host__ __device__ __forceinline__ int lds_byte(int r, int c) { const int st = (r >> 4) * 2 + (c >> 5), rr = r & 15, cc = c & 31, ob = rr * 64 + cc * 2; return st * 1024 + (ob ^ (((ob >> 9) & 1) << 5)); }
__host__ __device__ __forceinline__ void stage_rc(int b, int& R, int& C) { const int st = b / 1024, sb = b % 1024, swz = sb ^ (((sb >> 9) & 1) << 5); R = (st >> 1) * 16 + swz / 64; C = (st & 1) * 32 + (swz % 64) / 2; }
__host__ __device__ __forceinline__ int perm32(int rho) { const int n = rho >> 4, i = rho & 15; return 8 * (i >> 2) + 4 * n + (i & 3); }

struct Unit { int pm, pn, e, aux; };
struct Gemm { const void* A; const void* Bt; int kb, lda, ldb; };
typedef int i32x8 __attribute__((ext_vector_type(8)));
typedef int i32x4 __attribute__((ext_vector_type(4)));

struct StaticOrder {
    static constexpr bool GATHER = false;
    int nM, nN, nwg, G, c, nx, il, base, lim;
    __device__ void init(int M, int N, int G_, int c_, int nx_ = NXCD) { nM = M / BM; nN = N / BM; nwg = nM * nN; G = G_; c = c_; nx = nx_; il = 0; base = 0; lim = nwg; }
    __device__ bool next(int i, Unit& u) const {
        const long L = (long)i * G + c; if (!il && L >= nwg) return false;
        int wgid = (int)L;
        if (il) {
            const int px = G / nx, xcd = wgid % nx, off = wgid / nx; wgid = base + ((off / px) * nx + xcd) * px + (off % px); if (wgid >= lim) return false;
        } else { const int q = nwg / nx, r = nwg % nx, xcd = wgid % nx, off = wgid / nx; wgid = (xcd < r ? xcd * (q + 1) : r * (q + 1) + (xcd - r) * q) + off; }
        const int nig = WGM * nN, gid = wgid / nig, fm = gid * WGM, gsz = (nM - fm) < WGM ? (nM - fm) : WGM;
        u.pm = fm + ((wgid % nig) % gsz); u.pn = (wgid % nig) / gsz; u.e = 0; u.aux = 0; return true;
    }
    __device__ __forceinline__ int btile(const Unit& u) const { return u.pn; }
    __device__ __forceinline__ unsigned arow(const Unit&, int) const { return 0u; }
};

__device__ __forceinline__ unsigned cvt_pk_bf16(float lo, float hi) { unsigned r; asm volatile("v_cvt_pk_bf16_f32 %0, %1, %2" : "=v"(r) : "v"(lo), "v"(hi)); return r; }

struct EpiBf16Plain {
    static constexpr bool PERM = true;
    bf16_t* O; int ldc;
    __device__ __forceinline__ void operator()(const f32x4 (&acc)[2][2][4][2], const Unit& u, int wr, int wc, int fr, int fq) const {
        const int row0 = u.pm * BM + wr * 64 + fr, col0 = u.pn * BM + wc * 32 + 8 * fq;
#pragma unroll
        for (int ai = 0; ai < 2; ++ai)
#pragma unroll
            for (int m = 0; m < 4; ++m) { bf16_t* rowp = O + (size_t)(row0 + ai * HALF + m * 16) * ldc + col0;
#pragma unroll
                for (int bj = 0; bj < 2; ++bj) { const f32x4 v0 = acc[ai][bj][m][0], v1 = acc[ai][bj][m][1];
                    u32x4 w; w.x = cvt_pk_bf16(v0[0], v0[1]); w.y = cvt_pk_bf16(v0[2], v0[3]); w.z = cvt_pk_bf16(v1[0], v1[1]); w.w = cvt_pk_bf16(v1[2], v1[3]);
                    *(u32x4*)(rowp + bj * HALF) = w; } }
    }
};
struct EpiF32Res {
    static constexpr bool PERM = true;
    bf16_t* O; const float* X; int ldc, ldx; float alpha;
    __device__ __forceinline__ void operator()(const f32x4 (&acc)[2][2][4][2], const Unit& u, int wr, int wc, int fr, int fq) const {
        const int col0 = u.pn * BM + wc * 32 + 8 * fq;
#pragma unroll
        for (int ai = 0; ai < 2; ++ai)
#pragma unroll
            for (int m = 0; m < 4; ++m) { const size_t rowi = (size_t)(u.pm * BM + ai * HALF + wr * 64 + m * 16 + fr), off = rowi * ldc + col0, offx = rowi * ldx + col0;
#pragma unroll
                for (int bj = 0; bj < 2; ++bj) { const f32x4 x0 = *(const f32x4*)(X + offx + bj * HALF), x1 = *(const f32x4*)(X + offx + bj * HALF + 4);
                    const f32x4 v0 = acc[ai][bj][m][0] + x0 * alpha, v1 = acc[ai][bj][m][1] + x1 * alpha;
                    u32x4 w; w.x = cvt_pk_bf16(v0[0], v0[1]); w.y = cvt_pk_bf16(v0[2], v0[3]); w.z = cvt_pk_bf16(v1[0], v1[1]); w.w = cvt_pk_bf16(v1[2], v1[3]);
                    *(u32x4*)(O + off + bj * HALF) = w; } }
    }
};
__device__ __forceinline__ unsigned pk4_fp8(float a, float b, float c, float d) {
    a = fminf(fmaxf(a, -448.f), 448.f); b = fminf(fmaxf(b, -448.f), 448.f); c = fminf(fmaxf(c, -448.f), 448.f); d = fminf(fmaxf(d, -448.f), 448.f);
    unsigned w = 0u; w = __builtin_amdgcn_cvt_pk_fp8_f32(a, b, w, false); w = __builtin_amdgcn_cvt_pk_fp8_f32(c, d, w, true); return w;
}
struct EpiSwiglu {
    static constexpr bool PERM = true;
    unsigned char* O; const float* bup; float oscale; int ldo;
    __device__ __forceinline__ void operator()(const f32x4 (&acc)[2][2][4][2], const Unit& u, int wr, int wc, int fr, int fq) const {
        const int row0 = u.pm * BM + wr * 64 + fr, c0 = u.pn * HALF + wc * 32 + 8 * fq;
        const float* bg = bup + (size_t)u.e * 4096 + c0; const float* bu = bg + 2048;
        const f32x4 g0 = *(const f32x4*)bg, g1 = *(const f32x4*)(bg + 4), u0 = *(const f32x4*)bu, u1 = *(const f32x4*)(bu + 4);
#pragma unroll
        for (int ai = 0; ai < 2; ++ai)
#pragma unroll
            for (int m = 0; m < 4; ++m) { unsigned char* rowp = O + (size_t)(row0 + ai * HALF + m * 16) * ldo + c0;
                float r[8];
#pragma unroll
                for (int n = 0; n < 2; ++n) { const f32x4 gv = acc[ai][0][m][n] + (n ? g1 : g0), uv = acc[ai][1][m][n] + (n ? u1 : u0);
#pragma unroll
                    for (int j = 0; j < 4; ++j) { const float gate = fminf(gv[j], 7.0f), up = fminf(fmaxf(uv[j], -7.0f), 7.0f);
                        const float sg = __builtin_amdgcn_rcpf(1.0f + __builtin_amdgcn_exp2f(-2.4554669595930157f * gate)); r[n * 4 + j] = (up + 1.0f) * (gate * sg) * oscale; } }
                unsigned w0 = 0u, w1 = 0u;
                w0 = __builtin_amdgcn_cvt_pk_fp8_f32(r[0], r[1], w0, false); w0 = __builtin_amdgcn_cvt_pk_fp8_f32(r[2], r[3], w0, true);
                w1 = __builtin_amdgcn_cvt_pk_fp8_f32(r[4], r[5], w1, false); w1 = __builtin_amdgcn_cvt_pk_fp8_f32(r[6], r[7], w1, true);
                f32x2 st; st.x = __uint_as_float(w0); st.y = __uint_as_float(w1);
                *(f32x2*)rowp = st; }
    }
};
struct EpiBf16Bias {
    static constexpr bool PERM = true;
    unsigned char* O; const float* bdn; int ldo;
    __device__ __forceinline__ void operator()(const f32x4 (&acc)[2][2][4][2], const Unit& u, int wr, int wc, int fr, int fq) const {
        const int row0 = u.pm * BM + wr * 64 + fr, col0 = u.pn * BM + wc * 32 + 8 * fq;
        const float* bp = bdn + (size_t)u.e * 2048 + col0;
        f32x4 bv[2][2];
#pragma unroll
        for (int bj = 0; bj < 2; ++bj)
#pragma unroll
            for (int n = 0; n < 2; ++n) bv[bj][n] = *(const f32x4*)(bp + bj * HALF + 4 * n);
#pragma unroll
        for (int ai = 0; ai < 2; ++ai)
#pragma unroll
            for (int m = 0; m < 4; ++m) { unsigned char* rowp = O + (size_t)(row0 + ai * HALF + m * 16) * ldo + col0;
#pragma unroll
                for (int bj = 0; bj < 2; ++bj) { const f32x4 v0 = (acc[ai][bj][m][0] + bv[bj][0]) * 16.0f, v1 = (acc[ai][bj][m][1] + bv[bj][1]) * 16.0f;
                    f32x2 st; st.x = __uint_as_float(pk4_fp8(v0[0], v0[1], v0[2], v0[3])); st.y = __uint_as_float(pk4_fp8(v1[0], v1[1], v1[2], v1[3]));
                    *(f32x2*)(rowp + bj * HALF) = st; } }
    }
};

template <class Epi, class Sched, bool FP8 = false, int SCA = 0x7F7F7F7F, int SCB = 0x7F7F7F7F>
__device__ __forceinline__ void gemm_phase(PG8_LAS unsigned char* lds, const Gemm g, const Sched& S, const Epi& E) {
    constexpr bool GATHER = Sched::GATHER;
    const int tid = threadIdx.x, wid = __builtin_amdgcn_readfirstlane(tid >> 6), lane = tid & 63, wr = wid >> 2, wc = wid & 3, fr = lane & 15, fq = lane >> 4;
    const int lda = g.lda, ldb = g.ldb, nt = g.kb / (BK * 2);
    unsigned voffA[2], voffB[2]; int RA[2], CA[2];
#pragma unroll
    for (int i = 0; i < 2; ++i) { int R, C; stage_rc(tid * 16 + i * 8192, R, C); const int Rb = Epi::PERM ? ((R & ~31) + perm32(R & 31)) : R; RA[i] = R; CA[i] = C;
        voffA[i] = (unsigned)(R * lda + C * 2); voffB[i] = (unsigned)(Rb * ldb + C * 2); }
    const size_t kstep = (size_t)(BK * 2);
    const size_t hstepA = (size_t)HALF * lda, hstep = (size_t)HALF * ldb;
    const size_t tstep = 2 * hstep, tstepA = 2 * hstepA;
    const unsigned ldsw = (unsigned)wid * 1024u;
    const unsigned lds0 = (unsigned)__builtin_amdgcn_readfirstlane((int)((unsigned)(size_t)lds + ldsw));
    const int aoff = lds_byte(wr * 64 + fr, fq * 8), boff = lds_byte(wc * 32 + fr, fq * 8);
    const int a8o0 = lds_byte(wr * 64 + fr, 16 * fq + 8 * (fq & 1)), b8o0 = lds_byte(wc * 32 + fr, 16 * fq + 8 * (fq & 1));
#define a8o1 (a8o0 ^ 16)
#define b8o1 (b8o0 ^ 16)
#define PG8_SA(b, h) (((b) * 2 + (h)) * HTB)
#define PG8_SB(b, h) ((4 + (b) * 2 + (h)) * HTB)
#define PG8_STAGE(bufoff, gbase, voff) do { _Pragma("unroll") for (int _i = 0; _i < 2; ++_i) { unsigned _keep; \
        asm volatile("s_mov_b32 %0, m0\n\ts_mov_b32 m0, %3\n\ts_nop 0\n\tglobal_load_lds_dwordx4 %1, %2\n\ts_mov_b32 m0, %0" : "=&s"(_keep) : "v"((voff)[_i]), "s"((const char*)(gbase)), "s"(lds0 + (unsigned)((bufoff) + _i * 8192)) : "memory"); } } while (0)
#define PG8_STAGE_AC(bufoff, base, h) do { if constexpr (GATHER) PG8_STAGE(bufoff, base, vc[h]); else PG8_STAGE(bufoff, (base) + (h) * hstepA, voffA); } while (0)
#define PG8_STAGE_AS(bufoff, base, h) do { if constexpr (GATHER) PG8_STAGE(bufoff, base, s2[h]); else PG8_STAGE(bufoff, (base) + (h) * hstepA, voffA); } while (0)
#define PG8_Q8(p0, p1) ({ const i32x4 _lo = *(const PG8_LAS i32x4*)(p0), _hi = *(const PG8_LAS i32x4*)(p1); (i32x8){_lo[0], _lo[1], _lo[2], _lo[3], _hi[0], _hi[1], _hi[2], _hi[3]}; })
#define PG8_LDA(dst, b, h) do { if constexpr (FP8) { _Pragma("unroll") for (int m = 0; m < 4; ++m) Aq[m] = PG8_Q8(lds + PG8_SA(b, h) + a8o0 + m * 2048, lds + PG8_SA(b, h) + a8o1 + m * 2048); } \
        else { _Pragma("unroll") for (int m = 0; m < 4; ++m) _Pragma("unroll") for (int k = 0; k < 2; ++k) dst[m][k] = *(const PG8_LAS bf16x8*)(lds + PG8_SA(b, h) + aoff + m * 2048 + k * 1024); } } while (0)
#define PG8_LDB(dst, b, h) do { if constexpr (FP8) { _Pragma("unroll") for (int n = 0; n < 2; ++n) dst##q[n] = PG8_Q8(lds + PG8_SB(b, h) + b8o0 + n * 2048, lds + PG8_SB(b, h) + b8o1 + n * 2048); } \
        else { _Pragma("unroll") for (int n = 0; n < 2; ++n) _Pragma("unroll") for (int k = 0; k < 2; ++k) dst[n][k] = *(const PG8_LAS bf16x8*)(lds + PG8_SB(b, h) + boff + n * 2048 + k * 1024); } } while (0)
#define PG8_MMA(ai, bj, At, Bt) do { __builtin_amdgcn_s_setprio(1); if constexpr (FP8) { _Pragma("unroll") for (int m = 0; m < 4; ++m) _Pragma("unroll") for (int n = 0; n < 2; ++n) \
        asm volatile("v_mfma_scale_f32_16x16x128_f8f6f4 %0, %1, %2, %0, %3, %4 op_sel_hi:[0,0,0]" : "+v"(acc[ai][bj][m][n]) : "v"(Bt##q[n]), "v"(Aq[m]), "v"(scb_), "v"(sca_)); } \
        else { _Pragma("unroll") for (int m = 0; m < 4; ++m) _Pragma("unroll") for (int n = 0; n < 2; ++n) _Pragma("unroll") for (int k = 0; k < 2; ++k) \
        acc[ai][bj][m][n] = __builtin_amdgcn_mfma_f32_16x16x32_bf16(Bt[n][k], At[m][k], acc[ai][bj][m][n], 0, 0, 0); } __builtin_amdgcn_s_setprio(0); } while (0)
#define PG8_WAIT_V(n) asm volatile("s_waitcnt vmcnt(" #n ")" ::: "memory")
#define PG8_WAIT_L(n) asm volatile("s_waitcnt lgkmcnt(" #n ")" ::: "memory")
#define PG8_BAR __builtin_amdgcn_s_barrier()
#define PG8_SCHED __builtin_amdgcn_sched_barrier(0)
    Unit cur, nxt; int ui = 0;
    if (!S.next(0, cur)) return;
    f32x4 acc[2][2][4][2];
#pragma unroll
    for (int a = 0; a < 2; ++a)
#pragma unroll
        for (int b = 0; b < 2; ++b)
#pragma unroll
            for (int m = 0; m < 4; ++m)
#pragma unroll
                for (int n = 0; n < 2; ++n) acc[a][b][m][n] = (f32x4){0.f, 0.f, 0.f, 0.f};
    bf16x8 At[4][2], B0[2][2], B1[2][2]; i32x8 Aq[4], B0q[2], B1q[2];
    int sca_ = SCA, scb_ = SCB; asm volatile("" : "+v"(sca_), "+v"(scb_));
    unsigned vc[2][2], vn[2][2];
    if constexpr (GATHER) {
#pragma unroll
        for (int h = 0; h < 2; ++h)
#pragma unroll
            for (int i = 0; i < 2; ++i) { vc[h][i] = S.arow(cur, h * HALF + RA[i]) + (unsigned)CA[i] * 2u; vn[h][i] = vc[h][i]; }
    } else {
#pragma unroll
        for (int h = 0; h < 2; ++h)
#pragma unroll
            for (int i = 0; i < 2; ++i) { vc[h][i] = 0u; vn[h][i] = 0u; }
    }
    const char* cA = GATHER ? (const char*)g.A : (const char*)g.A + (size_t)cur.pm * tstepA; const char* cB = (const char*)g.Bt + (size_t)S.btile(cur) * tstep;
    PG8_STAGE(PG8_SB(0, 0), cB, voffB); PG8_STAGE(PG8_SB(0, 1), cB + hstep, voffB); PG8_STAGE_AC(PG8_SA(0, 0), cA, 0); PG8_STAGE_AC(PG8_SA(0, 1), cA, 1);
    if (wr == 1) PG8_BAR;
    PG8_WAIT_V(2); PG8_BAR;
    PG8_STAGE(PG8_SB(1, 0), cB + kstep, voffB); PG8_STAGE_AC(PG8_SA(1, 0), cA + kstep, 0); PG8_STAGE(PG8_SB(1, 1), cB + hstep + kstep, voffB);
    PG8_WAIT_V(6); PG8_BAR;
    for (;;) {
        const bool has_next = S.next(ui + 1, nxt);
        const char* nA = has_next ? (GATHER ? (const char*)g.A : (const char*)g.A + (size_t)nxt.pm * tstepA) : cA; const char* nB = has_next ? (const char*)g.Bt + (size_t)S.btile(nxt) * tstep : cB;
        if constexpr (GATHER) { if (has_next) {
#pragma unroll
            for (int h = 0; h < 2; ++h)
#pragma unroll
                for (int i = 0; i < 2; ++i) vn[h][i] = S.arow(nxt, h * HALF + RA[i]) + (unsigned)CA[i] * 2u; } }
        for (int t = 0; t < nt; t += 2) {
            const bool last = (t == nt - 2);
            const char* a1 = cA + (size_t)(t + 1) * kstep;
            const char* a2 = last ? nA : cA + (size_t)(t + 2) * kstep; const char* b2 = last ? nB : cB + (size_t)(t + 2) * kstep;
            const char* a3 = a2 + kstep; const char* b3 = b2 + kstep;
            unsigned s2[2][2];
#pragma unroll
            for (int h = 0; h < 2; ++h)
#pragma unroll
                for (int i = 0; i < 2; ++i) s2[h][i] = (GATHER && last) ? vn[h][i] : vc[h][i];
            PG8_LDB(B0, 0, 0); PG8_LDB(B1, 0, 1); PG8_SCHED; PG8_LDA(At, 0, 0); PG8_STAGE_AC(PG8_SA(1, 1), a1, 1);
            PG8_WAIT_V(8); PG8_WAIT_L(0); PG8_BAR; PG8_MMA(0, 0, At, B0); PG8_MMA(0, 1, At, B1); PG8_BAR; PG8_SCHED;
            PG8_LDA(At, 0, 1); PG8_STAGE(PG8_SB(0, 0), b2, voffB); PG8_STAGE(PG8_SB(0, 1), b2 + hstep, voffB); PG8_STAGE_AS(PG8_SA(0, 0), a2, 0);
            PG8_WAIT_V(8); PG8_WAIT_L(0); PG8_BAR; PG8_MMA(1, 0, At, B0); PG8_MMA(1, 1, At, B1); PG8_BAR; PG8_SCHED;
            PG8_LDB(B0, 1, 0); PG8_LDB(B1, 1, 1); PG8_SCHED; PG8_LDA(At, 1, 0); PG8_STAGE_AS(PG8_SA(0, 1), a2, 1);
            PG8_WAIT_V(8); PG8_WAIT_L(0); PG8_BAR; PG8_MMA(0, 0, At, B0); PG8_MMA(0, 1, At, B1); PG8_BAR; PG8_SCHED;
            PG8_LDA(At, 1, 1); PG8_STAGE(PG8_SB(1, 0), b3, voffB); PG8_STAGE(PG8_SB(1, 1), b3 + hstep, voffB); PG8_STAGE_AS(PG8_SA(1, 0), a3, 0);
            PG8_WAIT_V(8); PG8_WAIT_L(0); PG8_BAR; PG8_MMA(1, 0, At, B0); PG8_MMA(1, 1, At, B1); PG8_BAR; PG8_SCHED;
        }
        if (wr == 0) PG8_BAR;
        if constexpr (FP8) asm volatile("s_nop 15\n\ts_nop 15" ::: "memory");
        { int l2 = (int)__builtin_amdgcn_mbcnt_hi(~0u, __builtin_amdgcn_mbcnt_lo(~0u, 0u)); asm volatile("" : "+v"(l2));
          E(acc, cur, wr, wc, l2 & 15, l2 >> 4); }
        if (!has_next) break;
#pragma unroll
        for (int a = 0; a < 2; ++a)
#pragma unroll
            for (int b = 0; b < 2; ++b)
#pragma unroll
                for (int m = 0; m < 4; ++m)
#pragma unroll
                    for (int n = 0; n < 2; ++n) acc[a][b][m][n] = (f32x4){0.f, 0.f, 0.f, 0.f};
        cur = nxt; cA = nA; cB = nB; ++ui;
        if constexpr (GATHER) {
#pragma unroll
            for (int h = 0; h < 2; ++h)
#pragma unroll
                for (int i = 0; i < 2; ++i) vc[h][i] = vn[h][i]; }
        if (wr == 1) PG8_BAR;
    }
    PG8_WAIT_V(0);
    PG8_BAR;
#undef PG8_SA
#undef PG8_SB
#undef PG8_STAGE
#undef PG8_STAGE_AC
#undef PG8_STAGE_AS
#undef PG8_LDA
#undef PG8_Q8
#undef a8o1
#undef b8o1
#undef PG8_LDB
#undef PG8_MMA
#undef PG8_WAIT_V
#undef PG8_WAIT_L
#undef PG8_BAR
#undef PG8_SCHED
}
}

constexpr int NWAVES = 8;
constexpr int BATCH = 2, SEQ = 8192, NTOK = BATCH * SEQ, DM = 2048;
constexpr int NPROJ = 7168, INCOLS = 7176;
constexpr int C_QA = 0, C_KA = 1024, C_VA = 2048, C_QM = 3072, C_KM = 4096, C_VM = 5120, C_OM = 6144;
constexpr int NHA = 16, NHM = 4, DHM = 256;
constexpr int NEXP = 32, TOPK = 4, CAP = NTOK, MAXTILES = 288, NSLOT = MAXTILES * 256;
constexpr float DN_ALPHA = 1.189207115002721f;
constexpr float LN_EPS = 1e-5f, HN_EPS = 1e-6f;
constexpr int NPHASE = 11;
#ifndef XCONV
#define XCONV 3
#endif
#ifndef NCONV
#define NCONV 96
#endif
constexpr int LDX = DM;
#ifndef LDQ_PAD
#define LDQ_PAD 0
#endif
#ifndef LDP_PAD
#define LDP_PAD 0
#endif
#ifndef LDOG_PAD
#define LDOG_PAD 0
#endif
constexpr int LDQ = DM + LDQ_PAD;
constexpr int LDY = DM + 128;
constexpr int LDP = NPROJ + LDP_PAD;
constexpr int LDH = DM;
constexpr int LD8 = DM;
constexpr int LDOG = 1024 + LDOG_PAD;

constexpr size_t MiB = 1u << 20;
constexpr size_t WS_CTL = 0, CTL_ZERO_BYTES = 64 * 1024;
constexpr size_t WS_GATES = 1 * MiB;
constexpr size_t WS_BIAS = 1 * MiB + 512 * 1024;
constexpr size_t WS_TOKINFO = 2 * MiB;
constexpr size_t WS_LIST = 3 * MiB;
constexpr size_t WS_BCUM = 5 * MiB;
constexpr size_t WS_UCOL = WS_BCUM + 512 * 128 * 4;
constexpr size_t WS_CHS = WS_UCOL + 512 * 128 * 4;
constexpr size_t WS_NLOC = 6 * MiB;
constexpr size_t WS_NPREV = WS_NLOC + 512 * 256 * 4;
constexpr size_t WS_WRT = 7 * MiB;
constexpr size_t WS_RC = WS_WRT + 512 * 1024;
constexpr size_t WS_LSE = 8 * MiB;
constexpr size_t ws_up(size_t b) { return (b + MiB - 1) / MiB * MiB; }
constexpr size_t WS_WINT = 12 * MiB;
constexpr size_t WS_WOUTT = WS_WINT + ws_up((size_t)NPROJ * LDX * 2);
constexpr size_t WS_XB = WS_WOUTT + ws_up((size_t)DM * LDX * 2);
constexpr size_t WS_PROJ = WS_XB + ws_up((size_t)NTOK * LDX * 2);
constexpr size_t WS_QKM = WS_PROJ + ws_up((size_t)NTOK * LDP * 2);
constexpr size_t WS_Y = WS_QKM + ws_up((size_t)NTOK * LDQ * 2);
constexpr size_t WS_Z = WS_Y + ws_up((size_t)NTOK * LDY * 2);
constexpr size_t WS_H = WS_Z + ws_up((size_t)NTOK * LDX * 2);
constexpr size_t WS_HB = WS_H + ws_up((size_t)NTOK * LDH * 4);
constexpr size_t WS_ACT = WS_HB + ws_up((size_t)NTOK * LD8);
constexpr size_t WS_YS = WS_ACT + ws_up((size_t)NSLOT * LD8);
constexpr size_t WS_WUPT = WS_YS + ws_up((size_t)NSLOT * LD8);
constexpr size_t WS_WDNT = WS_WUPT + ws_up((size_t)NEXP * 4096 * LD8);
constexpr size_t WS_OG = WS_WDNT + ws_up((size_t)NEXP * DM * LD8);
constexpr size_t WS_CLOC = WS_OG + ws_up((size_t)3 * NTOK * LDOG * 2);
constexpr size_t WS_CPREV = WS_CLOC + 64 * MiB;
constexpr size_t WS_END = WS_CPREV + 64 * MiB;
constexpr int CW_TMO = 0, CW_CODE = 1;
constexpr int CW_BAR = 4096;
constexpr int CW_CONV = 12288;
constexpr int CW_CNT = 8192;

constexpr int RING_OFF = 0, RING_BYTES = 131072;
constexpr int SCR_BYTES = 151552;
constexpr int LDSCTL_OFF = SCR_BYTES, MISC_OFF = LDSCTL_OFF + 320;
constexpr int TAB_OFF = LDSCTL_OFF + 1024;
constexpr int LDS_BYTES = 155648;

#define GAS __attribute__((address_space(1)))
#define LAS __attribute__((address_space(3)))
typedef unsigned short bf16;
typedef unsigned v4u __attribute__((ext_vector_type(4)));
typedef unsigned v2u __attribute__((ext_vector_type(2)));
typedef float f32x4 __attribute__((ext_vector_type(4)));
typedef float f32x2_ __attribute__((ext_vector_type(2)));
typedef GAS unsigned gu32;
#define RLX_AGENT __ATOMIC_RELAXED, __HIP_MEMORY_SCOPE_AGENT
#define LDS_WAIT() asm volatile("s_waitcnt lgkmcnt(0)" ::: "memory")
#define VM_WAIT() asm volatile("s_waitcnt vmcnt(0)" ::: "memory")
typedef float f32x2p __attribute__((ext_vector_type(2))); typedef __bf16 bf16x2p __attribute__((ext_vector_type(2)));
__device__ __forceinline__ unsigned pk2(float lo, float hi) { const f32x2p v = {lo, hi}; return __builtin_bit_cast(unsigned, __builtin_convertvector(v, bf16x2p)); }
__device__ __forceinline__ unsigned f2bf(float f) { return pk2(f, 0.f) & 0xffffu; }
__device__ __forceinline__ float bflo(unsigned w) { return __uint_as_float(w << 16); }
__device__ __forceinline__ float bfhi(unsigned w) { return __uint_as_float(w & 0xffff0000u); }
__device__ __forceinline__ float bf1(bf16 b) { return __uint_as_float((unsigned)b << 16); }
__device__ __forceinline__ float wave_sum(float v) {
#pragma unroll
    for (int o = 1; o < 64; o <<= 1) v += __shfl_xor(v, o);
    return v;
}
__device__ __forceinline__ float wave_max(float v) {
#pragma unroll
    for (int o = 1; o < 64; o <<= 1) v = fmaxf(v, __shfl_xor(v, o));
    return v;
}

#define XB_TMO      128
#define XB_XCNT(j)  (256  + 64 * (j))
#define XB_XSUB(j)  (1280 + 64 * (j))
#define XB_XGEN(j)  (2304 + 64 * (j))
#define XB_TOP      3328
#define XB_TOPGEN   3392
#define XCD_BAR_WORDS 3456
#define XB_SPIN_CAP (1u << 18)
__device__ __forceinline__ unsigned xb_ld(unsigned* p)              { return __hip_atomic_load(p, __ATOMIC_RELAXED, __HIP_MEMORY_SCOPE_AGENT); }
__device__ __forceinline__ unsigned xb_add(unsigned* p, unsigned v) { return __hip_atomic_fetch_add(p, v, __ATOMIC_RELAXED, __HIP_MEMORY_SCOPE_AGENT); }
__device__ __forceinline__ unsigned xb_xcc_id() { return (unsigned)__builtin_amdgcn_s_getreg((3 << 11) | 20) & 0xFu; }
#define XB_SPIN(cond, bar) do { unsigned _sp = 0; while (cond) { __builtin_amdgcn_s_sleep(1); \
    if ((++_sp & 255u) == 0u) { if (xb_ld(&(bar)[XB_TMO])) break; if (_sp > XB_SPIN_CAP) { atomicAdd(&(bar)[XB_TMO], 1u); break; } } } } while (0)
struct XcdBarrier { unsigned* bar; unsigned x; volatile LAS unsigned* st; };
__device__ __forceinline__ XcdBarrier xcd_barrier_post(unsigned* bar, volatile LAS unsigned* st) {
    XcdBarrier b; b.bar = bar; b.x = xb_xcc_id(); b.st = st;
    if (threadIdx.x == 0) (void)xb_add(&bar[XB_XCNT(b.x)], 1u);
    return b;
}
__device__ __forceinline__ void xcd_barrier_complete(unsigned* bar, unsigned x, unsigned& nloc, unsigned& nx) {
    const unsigned G = gridDim.x * gridDim.y * gridDim.z;
    unsigned sum, cnt, mine, sp = 0u;
    for (;;) {
        sum = 0u; cnt = 0u; mine = 0u;
#pragma unroll
        for (unsigned j = 0; j < 16; ++j) { const unsigned c = xb_ld(&bar[XB_XCNT(j)]); sum += c; cnt += (c > 0u) ? 1u : 0u; mine = (j == x) ? c : mine; }
        if (sum == G) break;
        __builtin_amdgcn_s_sleep(1);
        if ((++sp & 255u) == 0u) { if (xb_ld(&bar[XB_TMO])) break; if (sp > XB_SPIN_CAP) { atomicAdd(&bar[XB_TMO], 1u); break; } }
    }
    nloc = mine > 0u ? mine : 1u; nx = cnt > 0u ? cnt : 1u;
}
__device__ __forceinline__ void xcd_barrier(const XcdBarrier& b) {
    asm volatile("s_waitcnt vmcnt(0)" ::: "memory");
    __syncthreads();
    if (threadIdx.x == 0) {
        unsigned* bar = b.bar;
        __builtin_amdgcn_s_waitcnt(0);
        unsigned nloc = b.st[0], nx = b.st[1];
        if (nloc == 0u) { xcd_barrier_complete(bar, b.x, nloc, nx); b.st[0] = nloc; b.st[1] = nx; }
        const unsigned old = xb_add(&bar[XB_XSUB(b.x)], 1u);
        const unsigned gen = old / nloc;
        if (old + 1u == (gen + 1u) * nloc) {
            __builtin_amdgcn_fence(__ATOMIC_RELEASE, "agent");
            asm volatile("s_waitcnt vmcnt(0)" ::: "memory");
            const unsigned og = xb_add(&bar[XB_TOP], 1u);
            const unsigned tg = og / nx;
            if (og + 1u == (tg + 1u) * nx) xb_add(&bar[XB_TOPGEN], 1u);
            else XB_SPIN(xb_ld(&bar[XB_TOPGEN]) == tg, bar);
            __builtin_amdgcn_fence(__ATOMIC_ACQUIRE, "agent");
            xb_add(&bar[XB_XGEN(b.x)], 1u);
            asm volatile("s_waitcnt vmcnt(0)" ::: "memory");
        } else {
            XB_SPIN(xb_ld(&bar[XB_XGEN(b.x)]) == gen, bar);
            __builtin_amdgcn_fence(__ATOMIC_ACQUIRE, "agent");
            asm volatile("s_waitcnt vmcnt(0)" ::: "memory");
        }
    }
    __syncthreads();
}

struct Args {
    const float *x, *w_in, *b_ig, *b_fg, *conv_w, *conv_b, *rel_bias, *beta_a, *beta_m, *w_out, *ln1_g, *ln1_b, *w_router, *b_router, *w_up, *b_up, *w_down, *b_down, *ln2_g, *ln2_b;
    float* out; unsigned char* ws; int ph_lo, ph_hi;
};
struct Frame {
    LAS unsigned char* lds;
    volatile LAS unsigned* MISC;
    gu32* ctl;
    int tid, lane, wave, vcu, G;
};

__device__ __forceinline__ void p0_transpose_item(const float* W, size_t ldw, bf16* WT, int K, int k0, int n0, int drow0, float scale, LAS float* scr, int lane) {
    float v[32];
#pragma unroll
    for (int i = 0; i < 32; ++i) { const int kk = 2 * i + (lane >> 5); v[i] = W[(size_t)(k0 + kk) * ldw + n0 + (lane & 31)]; }
#pragma unroll
    for (int i = 0; i < 32; ++i) { const int kk = 2 * i + (lane >> 5); scr[kk * 33 + (lane & 31)] = v[i] * scale; }
    LDS_WAIT(); asm volatile("" ::: "memory");
    const int c = lane & 7;
#pragma unroll
    for (int j = 0; j < 4; ++j) { const int n = (lane >> 3) + 8 * j; const LAS float* s = scr + (8 * c) * 33 + n;
        v4u o; o.x = pk2(s[0 * 33], s[1 * 33]); o.y = pk2(s[2 * 33], s[3 * 33]); o.z = pk2(s[4 * 33], s[5 * 33]); o.w = pk2(s[6 * 33], s[7 * 33]);
        *(GAS v4u*)(WT + (size_t)(drow0 + n) * K + k0 + 8 * c) = o; }
    LDS_WAIT(); asm volatile("" ::: "memory");
}
struct P0Item { const float* W; size_t ldw; unsigned char* WT; int k0, n0, drow0; float scale; };
__device__ __forceinline__ P0Item p0_item8(const Args& a, unsigned char* ws, int q) {
    constexpr int I_UP = 16 * 128, I_DN = 16 * 64; P0Item d;
    if (q < NEXP * I_UP) { const int e = q / I_UP, r = q % I_UP, kb = r / 128, nb = r % 128, n0 = 32 * nb, nn = n0 & 2047;
        d.W = a.w_up + (size_t)e * DM * 4096; d.ldw = 4096; d.WT = ws + WS_WUPT + (size_t)e * 4096 * LD8; d.k0 = 128 * kb; d.n0 = n0; d.drow0 = 256 * (nn >> 7) + (n0 >= 2048 ? 128 : 0) + (nn & 127); d.scale = 64.0f; }
    else { q -= NEXP * I_UP; const int e = q / I_DN, r = q % I_DN, kb = r / 64, nb = r % 64;
        d.W = a.w_down + (size_t)e * DM * DM; d.ldw = DM; d.WT = ws + WS_WDNT + (size_t)e * DM * LD8; d.k0 = 128 * kb; d.n0 = 32 * nb; d.drow0 = 32 * nb; d.scale = 128.0f; }
    return d;
}
__device__ __forceinline__ void p0_load8(const P0Item& d, float (&v)[64], int lane) {
#pragma unroll
    for (int i = 0; i < 64; ++i) { const int kk = 2 * i + (lane >> 5); v[i] = __builtin_nontemporal_load(d.W + (size_t)(d.k0 + kk) * d.ldw + d.n0 + (lane & 31)); }
}
__device__ __forceinline__ void p0_process8(const P0Item& d, const float (&v)[64], LAS float* scr, int lane) {
#pragma unroll
    for (int i = 0; i < 64; ++i) { const int kk = 2 * i + (lane >> 5); scr[kk * 33 + (lane & 31)] = v[i] * d.scale; }
    LDS_WAIT(); asm volatile("" ::: "memory");
    const int c = lane & 7;
#pragma unroll
    for (int j = 0; j < 4; ++j) { const int n = (lane >> 3) + 8 * j; const LAS float* s = scr + (16 * c) * 33 + n;
        v4u o; o.x = pg8::pk4_fp8(s[0 * 33], s[1 * 33], s[2 * 33], s[3 * 33]); o.y = pg8::pk4_fp8(s[4 * 33], s[5 * 33], s[6 * 33], s[7 * 33]);
        o.z = pg8::pk4_fp8(s[8 * 33], s[9 * 33], s[10 * 33], s[11 * 33]); o.w = pg8::pk4_fp8(s[12 * 33], s[13 * 33], s[14 * 33], s[15 * 33]);
        __builtin_nontemporal_store(o, (GAS v4u*)(d.WT + (size_t)(d.drow0 + n) * LD8 + d.k0 + 16 * c)); }
    LDS_WAIT(); asm volatile("" ::: "memory");
}
__device__ __forceinline__ void p0_prologue(Frame& F, const Args& a) {
    unsigned char* ws = a.ws;
    LAS float* scr = (LAS float*)(F.lds + RING_OFF + F.wave * 17408);
    const int gw = F.vcu * NWAVES + F.wave, NGW = F.G * NWAVES;
    constexpr int I_IN = 32 * 224, I_OUT = 32 * 64, I_UP = 16 * 128, I_DN = 16 * 64;
    for (int it = gw; it < I_IN + I_OUT; it += NGW) {
        int r = it;
        if (r < I_IN) { const int kb = r / 224, nb = r % 224; p0_transpose_item(a.w_in, INCOLS, (bf16*)(ws + WS_WINT), LDX, 64 * kb, 32 * nb, 32 * nb, (32 * nb < 1024) ? 0.125f * 1.4426950408889634f : 1.0f, scr, F.lane); continue; } r -= I_IN;
        { const int kb = r / 64, nb = r % 64; p0_transpose_item(a.w_out, DM, (bf16*)(ws + WS_WOUTT), LDX, 64 * kb, 32 * nb, 32 * nb, 1.0f, scr, F.lane); }
    }
    __syncthreads();
    LAS float* wgt = (LAS float*)(F.lds + RING_OFF);
    for (int i = F.tid; i < DM * 8; i += NWAVES * 64) { const int c = i >> 3, gq = i & 7; wgt[gq * DM + c] = a.w_in[(size_t)c * INCOLS + NPROJ + gq]; }
    __syncthreads();
    bf16* xb = (bf16*)(ws + WS_XB); float* gates = (float*)(ws + WS_GATES);
    for (int m = gw; m < NTOK; m += NGW) {
        const GAS f32x4* xr = (const GAS f32x4*)(a.x + (size_t)m * DM) + F.lane;
        f32x4 v[8];
#pragma unroll
        for (int j = 0; j < 8; ++j) v[j] = xr[64 * j];
        GAS v2u* o8 = (GAS v2u*)(xb + (size_t)m * LDX) + F.lane;
#pragma unroll
        for (int j = 0; j < 8; ++j) { v2u w; w.x = pk2(v[j].x, v[j].y); w.y = pk2(v[j].z, v[j].w); o8[64 * j] = w; }
        float mine = 0.f;
#pragma unroll 1
        for (int gq = 0; gq < 8; ++gq) { float s = 0.f;
#pragma unroll
            for (int j = 0; j < 8; ++j) { const f32x4 w = *(const LAS f32x4*)(wgt + gq * DM + 256 * j + 4 * F.lane); s += v[j].x * w.x + v[j].y * w.y + v[j].z * w.z + v[j].w * w.w; }
            s = wave_sum(s); if (F.lane == gq) mine = s; }
        if (F.lane < 8) gates[(size_t)m * 8 + F.lane] = mine + (F.lane < 4 ? a.b_ig[F.lane] : a.b_fg[F.lane - 4]);
    }
    { bf16* wrp = (bf16*)(ws + WS_WRT);
      for (int i = gw * 64 + F.lane; i < DM * NEXP; i += NGW * 64) { const int c = i >> 5, e = i & 31; const float f = a.w_router[i] * a.ln1_g[c];
          const unsigned u1 = pk2(f, 0.f) & 0xffffu; const unsigned u2 = pk2(f - bflo(u1), 0.f) & 0xffffu;
          wrp[(size_t)e * DM + c] = (bf16)u1; wrp[(size_t)NEXP * DM + (size_t)e * DM + c] = (bf16)u2; } }
    if (F.vcu == 0) {
        __syncthreads();
        LAS float* red = (LAS float*)(F.lds + RING_OFF);
        const int e = F.tid & 31, part = F.tid >> 5; float s1 = 0.f, s2 = 0.f;
        for (int k = part * 128; k < part * 128 + 128; ++k) { const float wv = a.w_router[(size_t)k * NEXP + e]; s1 += a.ln1_g[k] * wv; s2 += a.ln1_b[k] * wv; }
        red[part * 32 + e] = s1; red[512 + part * 32 + e] = s2;
        __syncthreads();
        if (F.tid < 32) { float t1 = 0.f, t2 = 0.f; for (int p = 0; p < 16; ++p) { t1 += red[p * 32 + F.tid]; t2 += red[512 + p * 32 + F.tid]; }
            float* rc = (float*)(ws + WS_RC); rc[F.tid] = t1; rc[32 + F.tid] = t2 + a.b_router[F.tid]; }
        __syncthreads();
    }
    float* bt = (float*)(ws + WS_BIAS);
    for (int i = gw * 64 + F.lane; i < 3 * 16 * 132; i += NGW * 64) {
        const int j = i % 132, h = (i / 132) % 16, gq = i / (132 * 16); const int dist = j * (gq == 0 ? 1 : (gq == 1 ? 4 : 16));
        int bucket;
        if (dist < 16) bucket = dist;
        else { const float df = (float)dist; int lg = 16 + (int)(logf(df / 16.0f) / 4.852030263919617f * 16.0f); bucket = lg < 31 ? lg : 31; }
        bt[i] = a.rel_bias[bucket * 16 + h] * 1.4426950408889634f;
    }
    __syncthreads();
}

struct ConvClaim { gu32* ctr; int cur, nxt, idx; };
__device__ __forceinline__ int conv_claim(gu32* ctr, int lane) { unsigned c = 0u; if (lane == 0) c = __hip_atomic_fetch_add((unsigned*)ctr, 1u, RLX_AGENT); return __builtin_amdgcn_readfirstlane((int)c); }
__device__ __forceinline__ int conv_next(ConvClaim& s, int lane) {
    constexpr int NCH = NEXP * (16 * 128 + 16 * 64) / 8;
    if (s.idx == 8) { s.cur = s.nxt; s.idx = 0; if (s.cur < NCH) s.nxt = conv_claim(s.ctr, lane); }
    if (s.cur >= NCH) return -1;
    return s.cur * 8 + s.idx++;
}
__device__ __forceinline__ void p1_convert_experts(Frame& F, const Args& a) {
    unsigned char* ws = a.ws;
    LAS float* scr = (LAS float*)(F.lds + RING_OFF + F.wave * 17408);
    ConvClaim s; s.ctr = F.ctl + CW_CONV; s.cur = conv_claim(s.ctr, F.lane); s.nxt = conv_claim(s.ctr, F.lane); s.idx = 0;
    float va[64], vb[64]; int q = conv_next(s, F.lane);
    if (q >= 0) { P0Item da = p0_item8(a, ws, q); p0_load8(da, va, F.lane);
        for (;;) {
            const int q2 = conv_next(s, F.lane); P0Item db = da; if (q2 >= 0) { db = p0_item8(a, ws, q2); p0_load8(db, vb, F.lane); }
            p0_process8(da, va, scr, F.lane);
            if (q2 < 0) break;
            const int q3 = conv_next(s, F.lane); if (q3 >= 0) { da = p0_item8(a, ws, q3); p0_load8(da, va, F.lane); }
            p0_process8(db, vb, scr, F.lane);
            if (q3 < 0) break;
        } }
    __syncthreads();
}

__device__ __forceinline__ void p2_conv(Frame& F, const Args& a) {
    const bf16* proj = (const bf16*)(a.ws + WS_PROJ); bf16* qkm = (bf16*)(a.ws + WS_QKM);
    const int cg = F.tid & 63, r0 = F.tid >> 6;
    for (int ch = F.vcu; ch < 512; ch += F.G) {
        const int bh = ch >> 6, c = ch & 63, b = bh >> 2, hh = bh & 3;
        const int c0 = (cg < 32 ? 0 : 1024) + hh * 256 + 8 * (cg & 31); const float sc = (c0 >= 1024) ? 0.0625f : 1.0f;
        f32x4 cw[4][2], cb[2];
#pragma unroll
        for (int i = 0; i < 4; ++i) { cw[i][0] = *(const f32x4*)(a.conv_w + (size_t)i * 2048 + c0); cw[i][1] = *(const f32x4*)(a.conv_w + (size_t)i * 2048 + c0 + 4); }
        cb[0] = *(const f32x4*)(a.conv_b + c0); cb[1] = *(const f32x4*)(a.conv_b + c0 + 4);
        for (int rr = r0; rr < 128; rr += 16) {
            const int ts[2] = {128 * c + rr, 128 * c + rr + 8};
            v4u pv[2][4];
#pragma unroll
            for (int r = 0; r < 2; ++r)
#pragma unroll
                for (int i = 0; i < 4; ++i) { const int dt = 3 - i; pv[r][i] = (ts[r] - dt >= 0) ? *(const GAS v4u*)(proj + (size_t)(b * SEQ + ts[r] - dt) * LDP + C_QM + c0) : (v4u){0u, 0u, 0u, 0u}; }
#pragma unroll
            for (int r = 0; r < 2; ++r) {
                float accv[8] = {cb[0].x, cb[0].y, cb[0].z, cb[0].w, cb[1].x, cb[1].y, cb[1].z, cb[1].w};
#pragma unroll
                for (int i = 0; i < 4; ++i) { const v4u p = pv[r][i]; const f32x4 w0 = cw[i][0], w1 = cw[i][1];
                    accv[0] += bflo(p.x) * w0.x; accv[1] += bfhi(p.x) * w0.y; accv[2] += bflo(p.y) * w0.z; accv[3] += bfhi(p.y) * w0.w;
                    accv[4] += bflo(p.z) * w1.x; accv[5] += bfhi(p.z) * w1.y; accv[6] += bflo(p.w) * w1.z; accv[7] += bfhi(p.w) * w1.w; }
#pragma unroll
                for (int j = 0; j < 8; ++j) { const float v = accv[j]; accv[j] = v * __builtin_amdgcn_rcpf(1.0f + __builtin_amdgcn_exp2f(-1.4426950408889634f * v)) * sc; }
                v4u o; o.x = pk2(accv[0], accv[1]); o.y = pk2(accv[2], accv[3]); o.z = pk2(accv[4], accv[5]); o.w = pk2(accv[6], accv[7]);
                *(GAS v4u*)(qkm + (size_t)(b * SEQ + ts[r]) * LDQ + c0) = o;
            }
        }
    }
    asm volatile("s_waitcnt vmcnt(0)" ::: "memory"); __syncthreads();
}


typedef short bf16x8_t __attribute__((ext_vector_type(8)));
typedef short s16x4_t __attribute__((ext_vector_type(4)));
constexpr int AT_PITCH = 160, AT_ROWS = 272, AT_K = 0, AT_V = AT_ROWS * AT_PITCH, AT_BIAS = 2 * AT_ROWS * AT_PITCH, AT_OST = AT_BIAS + 1024;
__device__ __forceinline__ s16x4_t lds_tr16(const LAS unsigned char* p) { return __builtin_bit_cast(s16x4_t, __builtin_amdgcn_ds_read_tr16_b64_v4i16((LAS s16x4_t*)p)); }
__device__ __forceinline__ bf16x8_t tr_frag(const LAS unsigned char* img, int pitch, int base_row, int col0, int lane) {
    const int i = lane & 15, g = lane >> 4, q = i >> 2, p = i & 3;
    const LAS unsigned char* a = img + (base_row + 4 * g + q) * pitch + (col0 + 4 * p) * 2;
    const s16x4_t lo = lds_tr16(a), hi = lds_tr16(a + 16 * pitch);
    return (bf16x8_t){lo[0], lo[1], lo[2], lo[3], hi[0], hi[1], hi[2], hi[3]};
}
struct AtUnit { int b, h, br, dil, r, n; };
__device__ __forceinline__ AtUnit at_decode(int u) {
    AtUnit t; const int bh = u / 192, rem = u % 192, blk = rem & 63; t.br = rem >> 6; t.b = bh >> 4; t.h = bh & 15;
    t.dil = t.br == 0 ? 1 : (t.br == 1 ? 4 : 16); const int nbk = 64 / t.dil; t.r = blk / nbk; t.n = blk % nbk; return t;
}
__device__ __forceinline__ void at_load(const AtUnit& t, const bf16* proj, const float* bt, int tid, int w, int qa, int g4, v4u (&kx)[4], v4u (&vx)[4], bf16x8_t (&qf)[2], float& bias) {
    const int piece = tid & 7;
#pragma unroll
    for (int i = 0; i < 4; ++i) { const int row = (tid >> 3) + 64 * i; const int m = 128 * (t.n - 1) + row;
        kx[i] = (v4u){0u, 0u, 0u, 0u}; vx[i] = (v4u){0u, 0u, 0u, 0u};
        if (m >= 0) { const bf16* rp = proj + (size_t)(t.b * SEQ + t.r + t.dil * m) * LDP + t.h * 64 + piece * 8; kx[i] = *(const GAS v4u*)(rp + C_KA); vx[i] = *(const GAS v4u*)(rp + C_VA); } }
    const size_t qrow = (size_t)(t.b * SEQ + t.r + t.dil * (128 * t.n + 16 * w + qa));
#pragma unroll
    for (int s = 0; s < 2; ++s) qf[s] = *(const GAS bf16x8_t*)(proj + qrow * LDP + C_QA + t.h * 64 + 32 * s + 8 * g4);
    bias = (tid < 132) ? bt[(t.br * 16 + t.h) * 132 + tid] : 0.f;
}
__device__ __forceinline__ void p3_attn_mfma(Frame& F, const Args& a) {
    const bf16* proj = (const bf16*)(a.ws + WS_PROJ); const float* bt = (const float*)(a.ws + WS_BIAS);
    bf16* og = (bf16*)(a.ws + WS_OG); float* lseo = (float*)(a.ws + WS_LSE);
    LAS unsigned char* L = F.lds + RING_OFF;
    const int w = F.wave; constexpr int NU = BATCH * NHA * 192;
    v4u kx[4], vx[4]; bf16x8_t qn[2]; float biasn;
    if (F.vcu < NU) { const AtUnit t0 = at_decode(F.vcu); at_load(t0, proj, bt, F.tid, w, F.lane & 15, F.lane >> 4, kx, vx, qn, biasn); }
    for (int u = F.vcu; u < NU; u += F.G) {
        int tid = F.tid; asm volatile("" : "+v"(tid));
        const int lane = tid & 63, qa = lane & 15, g4 = lane >> 4;
        const AtUnit t = at_decode(u); const int b = t.b, h = t.h, br = t.br, dil = t.dil, r = t.r, n = t.n;
        {
            const int piece = tid & 7;
#pragma unroll
            for (int i = 0; i < 4; ++i) { const int row = (tid >> 3) + 64 * i; *(LAS v4u*)(L + AT_K + row * AT_PITCH + piece * 16) = kx[i]; *(LAS v4u*)(L + AT_V + row * AT_PITCH + piece * 16) = vx[i]; }
            if (tid < 160) { *(LAS v4u*)(L + AT_K + 256 * AT_PITCH + tid * 16) = (v4u){0u, 0u, 0u, 0u}; *(LAS v4u*)(L + AT_V + 256 * AT_PITCH + tid * 16) = (v4u){0u, 0u, 0u, 0u}; }
            if (tid < 132) ((LAS float*)(L + AT_BIAS))[tid] = biasn;
        }
        bf16x8_t qf[2]; qf[0] = qn[0]; qf[1] = qn[1];
        const size_t qrow = (size_t)(b * SEQ + r + dil * (128 * n + 16 * w + qa));
        __syncthreads();
        if (u + F.G < NU) { const AtUnit tn = at_decode(u + F.G); at_load(tn, proj, bt, tid, w, qa, g4, kx, vx, qn, biasn); }
        f32x4 sc[10];
        const LAS float* bl = (const LAS float*)(L + AT_BIAS);
        { const int jb = 128 + qa - 4 * g4;
          const LAS float* blw = bl + (jb - 115);
#pragma unroll
          for (int rg = 0; rg < 4; ++rg) { const int j0 = jb - rg, j8 = jb - 128 - rg; sc[0][rg] = bl[j0 < 128 ? j0 : 128]; sc[8][rg] = bl[j8 > 0 ? j8 : 0]; }
#pragma unroll
          for (int kb = 1; kb < 8; ++kb)
#pragma unroll
              for (int rg = 0; rg < 4; ++rg) sc[kb][rg] = blw[16 * (7 - kb) + (3 - rg)];
          const LAS unsigned char* kbase = L + AT_K + (16 * w + qa) * AT_PITCH + 16 * g4;
#pragma unroll
          for (int hb = 0; hb < 9; hb += 3) { bf16x8_t k0[3], k1[3];
#pragma unroll
              for (int i = 0; i < 3; ++i) { k0[i] = *(const LAS bf16x8_t*)(kbase + (hb + i) * 16 * AT_PITCH); k1[i] = *(const LAS bf16x8_t*)(kbase + (hb + i) * 16 * AT_PITCH + 64); }
#pragma unroll
              for (int i = 0; i < 3; ++i) { const f32x4 sv = __builtin_amdgcn_mfma_f32_16x16x32_bf16(k0[i], qf[0], sc[hb + i], 0, 0, 0);
                  sc[hb + i] = __builtin_amdgcn_mfma_f32_16x16x32_bf16(k1[i], qf[1], sv, 0, 0, 0); } }
          const bool npos = n > 0;
#pragma unroll
          for (int rg = 0; rg < 4; ++rg) { const int c = 4 * g4 + rg;
              sc[0][rg] = (npos && qa <= c) ? sc[0][rg] : -1e30f;
              sc[8][rg] = (qa >= c) ? sc[8][rg] : -1e30f; }
          if (!npos) {
#pragma unroll
              for (int kb = 1; kb < 8; ++kb) { const bool okb = (w + kb >= 8);
#pragma unroll
                  for (int rg = 0; rg < 4; ++rg) sc[kb][rg] = okb ? sc[kb][rg] : -1e30f; } } }
        float mx = -1e30f;
#pragma unroll
        for (int kb = 0; kb < 9; ++kb) mx = fmaxf(mx, fmaxf(fmaxf(sc[kb][0], sc[kb][1]), fmaxf(sc[kb][2], sc[kb][3])));
        mx = fmaxf(mx, __shfl_xor(mx, 16)); mx = fmaxf(mx, __shfl_xor(mx, 32));
        float den = 0.f;
#pragma unroll
        for (int kb = 0; kb < 9; ++kb)
#pragma unroll
            for (int rg = 0; rg < 4; ++rg) { const float p = __builtin_amdgcn_exp2f(sc[kb][rg] - mx); sc[kb][rg] = p; den += p; }
        sc[9] = (f32x4){0.f, 0.f, 0.f, 0.f};
        den += __shfl_xor(den, 16); den += __shfl_xor(den, 32);
        f32x4 o[4];
#pragma unroll
        for (int c = 0; c < 4; ++c) o[c] = (f32x4){0.f, 0.f, 0.f, 0.f};
#pragma unroll
        for (int pp = 0; pp < 5; ++pp) {
            unsigned pw[4]; pw[0] = pk2(sc[2 * pp][0], sc[2 * pp][1]); pw[1] = pk2(sc[2 * pp][2], sc[2 * pp][3]); pw[2] = pk2(sc[2 * pp + 1][0], sc[2 * pp + 1][1]); pw[3] = pk2(sc[2 * pp + 1][2], sc[2 * pp + 1][3]);
            const bf16x8_t pf = __builtin_bit_cast(bf16x8_t, (v4u){pw[0], pw[1], pw[2], pw[3]});
#pragma unroll
            for (int c = 0; c < 4; ++c) { const bf16x8_t vf = tr_frag(L + AT_V, AT_PITCH, 16 * (w + 2 * pp), 16 * c, lane); o[c] = __builtin_amdgcn_mfma_f32_16x16x32_bf16(pf, vf, o[c], 0, 0, 0); }
        }
        { LAS float* P = (LAS float*)(L + AT_OST + w * (16 * 68 * 4));
#pragma unroll
          for (int c = 0; c < 4; ++c)
#pragma unroll
              for (int rg = 0; rg < 4; ++rg) P[(4 * g4 + rg) * 68 + 16 * c + qa] = o[c][rg];
          const float inv = 1.0f / den;
          bf16* op = og + ((size_t)br * NTOK + qrow) * LDOG + h * 64;
#pragma unroll
          for (int i = 0; i < 2; ++i) { const int pc = g4 + 4 * i; const f32x4 v0 = *(const LAS f32x4*)(P + qa * 68 + 8 * pc), v1 = *(const LAS f32x4*)(P + qa * 68 + 8 * pc + 4);
              v4u ow; ow.x = pk2(v0[0] * inv, v0[1] * inv); ow.y = pk2(v0[2] * inv, v0[3] * inv); ow.z = pk2(v1[0] * inv, v1[1] * inv); ow.w = pk2(v1[2] * inv, v1[3] * inv);
              *(GAS v4u*)(op + 8 * pc) = ow; } }
        if (g4 == 0) lseo[((size_t)br * NTOK + qrow) * 16 + h] = (mx + __log2f(den)) * 0.6931471805599453f;
        __syncthreads();
    }
}
__device__ __forceinline__ void p4_attn_combine(Frame& F, const Args& a) {
    const bf16* og = (const bf16*)(a.ws + WS_OG); const float* lse = (const float*)(a.ws + WS_LSE); bf16* yb = (bf16*)(a.ws + WS_Y);
    const int gw = F.vcu * NWAVES + F.wave, NGW = F.G * NWAVES, lane = F.lane, h = lane >> 2;
    f32x4 be[4];
#pragma unroll
    for (int i = 0; i < 4; ++i) be[i] = *(const f32x4*)(a.beta_a + lane * 16 + 4 * i);
    for (int m0 = gw; m0 < NTOK; m0 += 2 * NGW) {
        const int mr[2] = {m0, (m0 + NGW < NTOK) ? m0 + NGW : m0};
        float ls[2][3]; v4u pv[2][3][2];
#pragma unroll
        for (int r = 0; r < 2; ++r)
#pragma unroll
            for (int br = 0; br < 3; ++br) { ls[r][br] = lse[((size_t)br * NTOK + mr[r]) * 16 + h]; const GAS v4u* p = (const GAS v4u*)(og + ((size_t)br * NTOK + mr[r]) * LDOG + lane * 16); pv[r][br][0] = p[0]; pv[r][br][1] = p[1]; }
#pragma unroll
        for (int r = 0; r < 2; ++r) {
            const float l0 = ls[r][0], l1 = ls[r][1], l2 = ls[r][2];
            const float M = fmaxf(fmaxf(l0, l1), l2); float w0 = __expf(l0 - M), w1 = __expf(l1 - M), w2 = __expf(l2 - M); const float iw = 1.0f / (w0 + w1 + w2); w0 *= iw; w1 *= iw; w2 *= iw;
            float o[16];
#pragma unroll
            for (int j = 0; j < 16; ++j) o[j] = 0.f;
#pragma unroll
            for (int br = 0; br < 3; ++br) { const float wg = br == 0 ? w0 : (br == 1 ? w1 : w2);
#pragma unroll
                for (int c = 0; c < 2; ++c) { const v4u v = pv[r][br][c]; o[8 * c] += wg * bflo(v.x); o[8 * c + 1] += wg * bfhi(v.x); o[8 * c + 2] += wg * bflo(v.y); o[8 * c + 3] += wg * bfhi(v.y); o[8 * c + 4] += wg * bflo(v.z); o[8 * c + 5] += wg * bfhi(v.z); o[8 * c + 6] += wg * bflo(v.w); o[8 * c + 7] += wg * bfhi(v.w); } }
            float ss = 0.f;
#pragma unroll
            for (int j = 0; j < 16; ++j) ss += o[j] * o[j];
            ss += __shfl_xor(ss, 1); ss += __shfl_xor(ss, 2);
            const float rs = rsqrtf(ss * (1.0f / 64.0f) + HN_EPS);
            v4u w0v, w1v;
            w0v.x = pk2(o[0] * rs * be[0].x, o[1] * rs * be[0].y); w0v.y = pk2(o[2] * rs * be[0].z, o[3] * rs * be[0].w); w0v.z = pk2(o[4] * rs * be[1].x, o[5] * rs * be[1].y); w0v.w = pk2(o[6] * rs * be[1].z, o[7] * rs * be[1].w);
            w1v.x = pk2(o[8] * rs * be[2].x, o[9] * rs * be[2].y); w1v.y = pk2(o[10] * rs * be[2].z, o[11] * rs * be[2].w); w1v.z = pk2(o[12] * rs * be[3].x, o[13] * rs * be[3].y); w1v.w = pk2(o[14] * rs * be[3].z, o[15] * rs * be[3].w);
            if (r == 0 || mr[1] != mr[0]) { GAS v4u* yo = (GAS v4u*)(yb + (size_t)mr[r] * LDY + lane * 16); yo[0] = w0v; yo[1] = w1v; }
        }
    }
}


constexpr int ML_PITCH = 544, ML_IMG = 128 * ML_PITCH, ML_K = 0, ML_V = ML_IMG, ML_SM = 2 * ML_IMG;
constexpr int SM_B = 0, SM_U = 128, SM_MR = 256, SM_WS = 384, SM_NL = 512;
__device__ __forceinline__ float wave_incl_sum(float v, int lane) {
#pragma unroll
    for (int o = 1; o < 64; o <<= 1) { const float t = __shfl_up(v, o); if (lane >= o) v += t; }
    return v;
}
__device__ __forceinline__ float wave_incl_max(float v, int lane) {
#pragma unroll
    for (int o = 1; o < 64; o <<= 1) { const float t = __shfl_up(v, o); if (lane >= o) v = fmaxf(v, t); }
    return v;
}
__device__ __forceinline__ void ml_load128(v4u (&r)[8], const bf16* src, size_t ld, int tid) {
    const int piece = tid & 31;
#pragma unroll
    for (int i = 0; i < 8; ++i) { const int row = (tid >> 5) + 16 * i; r[i] = *(const GAS v4u*)(src + (size_t)row * ld + piece * 8); }
}
__device__ __forceinline__ void ml_store128(LAS unsigned char* img, const v4u (&r)[8], int tid, const LAS float* rowscale) {
    const int piece = tid & 31;
#pragma unroll
    for (int i = 0; i < 8; ++i) { const int row = (tid >> 5) + 16 * i; v4u v = r[i];
        if (rowscale) { const float s = rowscale[row];
            v.x = pk2(bflo(v.x) * s, bfhi(v.x) * s); v.y = pk2(bflo(v.y) * s, bfhi(v.y) * s); v.z = pk2(bflo(v.z) * s, bfhi(v.z) * s); v.w = pk2(bflo(v.w) * s, bfhi(v.w) * s); }
        *(LAS v4u*)(img + row * ML_PITCH + piece * 16) = v; }
}
__device__ __forceinline__ void p3_mlstm_local(Frame& F, const Args& a) {
    const bf16* proj = (const bf16*)(a.ws + WS_PROJ); const bf16* qkm = (const bf16*)(a.ws + WS_QKM); const float* gates = (const float*)(a.ws + WS_GATES);
    bf16* cloc = (bf16*)(a.ws + WS_CLOC); float* bcum = (float*)(a.ws + WS_BCUM); float* ucol = (float*)(a.ws + WS_UCOL); float* chs = (float*)(a.ws + WS_CHS); float* nloc = (float*)(a.ws + WS_NLOC);
    LAS unsigned char* L = F.lds + RING_OFF; LAS float* sm = (LAS float*)(L + ML_SM);
    const int w = F.wave;
    v4u kx[8], vx[8]; float ig0 = 0.f, fg0 = 0.f, ig1 = 0.f, fg1 = 0.f;
    auto issue = [&](int chn, int tidn) {
        const int bhn = chn >> 6, cn = chn & 63, bn = bhn >> 2, hn = bhn & 3; const size_t rown = (size_t)bn * SEQ + 128 * cn;
        ml_load128(kx, qkm + rown * LDQ + 1024 + hn * 256, LDQ, tidn); ml_load128(vx, proj + rown * LDP + C_VM + hn * 256, LDP, tidn);
        if (w == 0) { const int s0n = 2 * (tidn & 63);
            ig0 = gates[(rown + s0n) * 8 + hn]; fg0 = gates[(rown + s0n) * 8 + 4 + hn]; ig1 = gates[(rown + s0n + 1) * 8 + hn]; fg1 = gates[(rown + s0n + 1) * 8 + 4 + hn]; } };
    if (F.vcu < 512) issue(F.vcu, F.tid);
    for (int ch = F.vcu; ch < 512; ch += F.G) {
        int tid = F.tid; asm volatile("" : "+v"(tid));
        const int lane = tid & 63, qa = lane & 15, g4 = lane >> 4;
        const int bh = ch >> 6, c = ch & 63, b = bh >> 2, hh = bh & 3; const size_t row0 = (size_t)b * SEQ + 128 * c;
        if (w == 0) {
            const int s0 = 2 * lane;
            const float lf0 = fminf(fg0, 0.f) - log1pf(expf(-fabsf(fg0))), lf1 = fminf(fg1, 0.f) - log1pf(expf(-fabsf(fg1)));
            const float incl = wave_incl_sum(lf0 + lf1, lane), b1 = incl, b0 = incl - lf1, gsum = __shfl(incl, 63);
            const float u0 = ig0 - b0, u1 = ig1 - b1, umax = wave_max(fmaxf(u0, u1));
            sm[SM_B + s0] = b0; sm[SM_B + s0 + 1] = b1; sm[SM_U + s0] = u0; sm[SM_U + s0 + 1] = u1; sm[SM_WS + s0] = expf(u0 - umax); sm[SM_WS + s0 + 1] = expf(u1 - umax);
            bcum[(size_t)ch * 128 + s0] = b0; bcum[(size_t)ch * 128 + s0 + 1] = b1; ucol[(size_t)ch * 128 + s0] = u0; ucol[(size_t)ch * 128 + s0 + 1] = u1;
            if (lane == 0) { chs[ch] = gsum; chs[512 + ch] = gsum + umax; }
        }
        ml_store128(L + ML_K, kx, tid, nullptr);
        __syncthreads();
        ml_store128(L + ML_V, vx, tid, sm + SM_WS);
        __syncthreads();
        if (ch + F.G < 512) issue(ch + F.G, tid);
        if (tid < 256) { float acc = 0.f;
            for (int s = 0; s < 128; ++s) acc += sm[SM_WS + s] * bf1(*(const LAS bf16*)(L + ML_K + s * ML_PITCH + tid * 2));
            nloc[(size_t)ch * 256 + tid] = acc; }
        f32x4 acc[2][16];
#pragma unroll
        for (int i = 0; i < 2; ++i)
#pragma unroll
            for (int cb = 0; cb < 16; ++cb) acc[i][cb] = (f32x4){0.f, 0.f, 0.f, 0.f};
#pragma unroll 1
        for (int ks = 0; ks < 4; ++ks) {
            const bf16x8_t a0 = tr_frag(L + ML_V, ML_PITCH, 32 * ks, 16 * (2 * w), lane), a1 = tr_frag(L + ML_V, ML_PITCH, 32 * ks, 16 * (2 * w + 1), lane);
#pragma unroll
            for (int cb = 0; cb < 16; ++cb) { const bf16x8_t kf = tr_frag(L + ML_K, ML_PITCH, 32 * ks, 16 * cb, lane);
                acc[0][cb] = __builtin_amdgcn_mfma_f32_16x16x32_bf16(a0, kf, acc[0][cb], 0, 0, 0); acc[1][cb] = __builtin_amdgcn_mfma_f32_16x16x32_bf16(a1, kf, acc[1][cb], 0, 0, 0); }
        }
        bf16* ct = cloc + (size_t)ch * 65536;
#pragma unroll
        for (int i = 0; i < 2; ++i)
#pragma unroll
            for (int cb = 0; cb < 16; ++cb) { v2u o; o.x = pk2(acc[i][cb][0], acc[i][cb][1]); o.y = pk2(acc[i][cb][2], acc[i][cb][3]);
                *(GAS v2u*)(ct + (size_t)(16 * cb + qa) * 256 + 16 * (2 * w + i) + 4 * g4) = o; }
        __syncthreads();
    }
}
__device__ __forceinline__ void p4_mlstm_scan(Frame& F, const Args& a) {
    const bf16* cloc = (const bf16*)(a.ws + WS_CLOC); bf16* cprev = (bf16*)(a.ws + WS_CPREV); float* chs = (float*)(a.ws + WS_CHS);
    const float* nloc = (const float*)(a.ws + WS_NLOC); float* nprev = (float*)(a.ws + WS_NPREV);
    LAS float* AB = (LAS float*)(F.lds + RING_OFF);
    for (int it0 = F.vcu * 512; it0 < 8 * 16384; it0 += F.G * 512) {
        const int bh = it0 >> 14, e4 = (it0 & 16383) + F.tid;
        __syncthreads();
        if (F.tid < 64) {
            const int c = F.tid; const float gc = chs[bh * 64 + c], mlc = chs[512 + bh * 64 + c];
            const float G = wave_incl_sum(gc, c); const float pm = wave_incl_max(mlc - G, c); const float mc = G + fmaxf(0.f, pm);
            float mp = __shfl_up(mc, 1); if (c == 0) mp = 0.f;
            AB[c] = expf(gc + mp - mc); AB[64 + c] = expf(mlc - mc);
            if ((it0 & 16383) == 0) chs[1024 + bh * 64 + c] = mp;
        }
        __syncthreads();
        float s0 = 0.f, s1 = 0.f, s2 = 0.f, s3 = 0.f;
        const bf16* src = cloc + (size_t)bh * 64 * 65536 + e4 * 4; bf16* dst = cprev + (size_t)bh * 64 * 65536 + e4 * 4;
#pragma unroll 1
        for (int c0 = 0; c0 < 64; c0 += 32) {
            v2u x[32];
#pragma unroll
            for (int i = 0; i < 32; ++i) x[i] = __builtin_nontemporal_load((const GAS v2u*)(src + (size_t)(c0 + i) * 65536));
#pragma unroll
            for (int i = 0; i < 32; ++i) { const int c = c0 + i;
                v2u o; o.x = pk2(s0, s1); o.y = pk2(s2, s3); *(GAS v2u*)(dst + (size_t)c * 65536) = o;
                const float A = AB[c], B = AB[64 + c];
                s0 = A * s0 + B * bflo(x[i].x); s1 = A * s1 + B * bfhi(x[i].x); s2 = A * s2 + B * bflo(x[i].y); s3 = A * s3 + B * bfhi(x[i].y); }
        }
        if ((it0 & 16383) == 0 && F.tid < 256) {
            const int dk = F.tid; float s = 0.f;
            float nl[64];
#pragma unroll
            for (int c = 0; c < 64; ++c) nl[c] = nloc[(size_t)(bh * 64 + c) * 256 + dk];
#pragma unroll
            for (int c = 0; c < 64; ++c) { nprev[(size_t)(bh * 64 + c) * 256 + dk] = s; s = AB[c] * s + AB[64 + c] * nl[c]; }
        }
    }
    __syncthreads();
}
template <int MODE> __device__ __forceinline__ void p5_mlstm_out(Frame& F, const Args& a) {
    const bf16* proj = (const bf16*)(a.ws + WS_PROJ); const bf16* qkm = (const bf16*)(a.ws + WS_QKM); const bf16* cprev = (const bf16*)(a.ws + WS_CPREV);
    const float* bcum = (const float*)(a.ws + WS_BCUM); const float* ucol = (const float*)(a.ws + WS_UCOL); const float* chs = (const float*)(a.ws + WS_CHS); const float* nprev = (const float*)(a.ws + WS_NPREV);
    bf16* yb = (bf16*)(a.ws + WS_Y);
    LAS unsigned char* L = F.lds + RING_OFF; LAS float* sm = (LAS float*)(L + ML_SM);
    const int w = F.wave;
    for (int ch = F.vcu; ch < 512; ch += F.G) {
        int tid = F.tid; asm volatile("" : "+v"(tid));
        const int lane = tid & 63, qa = lane & 15, g4 = lane >> 4;
        const int bh = ch >> 6, c = ch & 63, b = bh >> 2, hh = bh & 3; const size_t row0 = (size_t)b * SEQ + 128 * c;
        const float mprev = chs[1024 + ch];
        v4u kx[8], vx[8];
        ml_load128(kx, qkm + row0 * LDQ + 1024 + hh * 256, LDQ, tid); ml_load128(vx, proj + row0 * LDP + C_VM + hh * 256, LDP, tid);
        const size_t trow = row0 + 16 * w + qa;
        bf16x8_t qf[8];
#pragma unroll
        for (int ks = 0; ks < 8; ++ks) { const bf16* qp = qkm + trow * LDQ + hh * 256 + 32 * ks + 4 * g4; const v2u lo = *(const GAS v2u*)qp, hi = *(const GAS v2u*)(qp + 16);
            qf[ks] = __builtin_bit_cast(bf16x8_t, (v4u){lo.x, lo.y, hi.x, hi.y}); }
        if (w == 0) {
            const int s0 = 2 * lane;
            const float b0 = bcum[(size_t)ch * 128 + s0], b1 = bcum[(size_t)ch * 128 + s0 + 1], u0 = ucol[(size_t)ch * 128 + s0], u1 = ucol[(size_t)ch * 128 + s0 + 1];
            const float incl = wave_incl_max(fmaxf(u0, u1), lane); float excl = __shfl_up(incl, 1); if (lane == 0) excl = -3.0e38f;
            sm[SM_B + s0] = b0; sm[SM_B + s0 + 1] = b1; sm[SM_U + s0] = u0; sm[SM_U + s0 + 1] = u1;
            sm[SM_MR + s0] = fmaxf(mprev, fmaxf(excl, u0)); sm[SM_MR + s0 + 1] = fmaxf(mprev, incl);
        } else if (w <= 4) { const int dk = (w - 1) * 64 + lane; sm[SM_NL + dk] = nprev[(size_t)ch * 256 + dk]; }
        ml_store128(L + ML_K, kx, tid, nullptr); ml_store128(L + ML_V, vx, tid, nullptr);
        __syncthreads();
        if (MODE == 1) { asm volatile("" :: "v"(qf[0]), "v"(qf[7])); __syncthreads(); continue; }
        const float Mt = sm[SM_MR + 16 * w + qa], bt_ = sm[SM_B + 16 * w + qa];
        f32x4 sc[8]; float rsum = 0.f;
#pragma unroll
        for (int sb = 0; sb < 8; ++sb) {
            f32x4 s = (f32x4){0.f, 0.f, 0.f, 0.f};
            if (sb <= w) {
#pragma unroll
                for (int ks = 0; ks < 8; ++ks) { const LAS unsigned char* kp = L + ML_K + (16 * sb + qa) * ML_PITCH + (32 * ks + 4 * g4) * 2;
                    const v2u lo = *(const LAS v2u*)kp, hi = *(const LAS v2u*)(kp + 32);
                    s = __builtin_amdgcn_mfma_f32_16x16x32_bf16(__builtin_bit_cast(bf16x8_t, (v4u){lo.x, lo.y, hi.x, hi.y}), qf[ks], s, 0, 0, 0); }
                const f32x4 uv = *(const LAS f32x4*)(sm + SM_U + 16 * sb + 4 * g4);
#pragma unroll
                for (int rg = 0; rg < 4; ++rg) { const bool ok = (16 * sb + 4 * g4 + rg) <= 16 * w + qa;
                    const float wv = ok ? __expf(uv[rg] - Mt) * s[rg] : 0.f; s[rg] = wv; rsum += wv; }
            }
            sc[sb] = s;
        }
        rsum += __shfl_xor(rsum, 16); rsum += __shfl_xor(rsum, 32);
        float nq = 0.f;
#pragma unroll
        for (int ks = 0; ks < 8; ++ks) { const f32x4 n0 = *(const LAS f32x4*)(sm + SM_NL + 32 * ks + 4 * g4), n1 = *(const LAS f32x4*)(sm + SM_NL + 32 * ks + 16 + 4 * g4);
            const v4u qw = __builtin_bit_cast(v4u, qf[ks]);
            nq += n0.x * bflo(qw.x) + n0.y * bfhi(qw.x) + n0.z * bflo(qw.y) + n0.w * bfhi(qw.y) + n1.x * bflo(qw.z) + n1.y * bfhi(qw.z) + n1.z * bflo(qw.w) + n1.w * bfhi(qw.w); }
        nq += __shfl_xor(nq, 16); nq += __shfl_xor(nq, 32);
        const float decay = expf(mprev - Mt), den = rsum + decay * nq, scale = 1.0f / fmaxf(fabsf(den), expf(-(bt_ + Mt)));
#pragma unroll
        for (int ks = 0; ks < 8; ++ks) { v4u qw = __builtin_bit_cast(v4u, qf[ks]);
            qw.x = pk2(bflo(qw.x) * decay, bfhi(qw.x) * decay); qw.y = pk2(bflo(qw.y) * decay, bfhi(qw.y) * decay); qw.z = pk2(bflo(qw.z) * decay, bfhi(qw.z) * decay); qw.w = pk2(bflo(qw.w) * decay, bfhi(qw.w) * decay);
            qf[ks] = __builtin_bit_cast(bf16x8_t, qw); }
        if (MODE == 2) { _Pragma("unroll") for (int i_ = 0; i_ < 8; ++i_) asm volatile("" :: "v"(sc[i_]), "v"(qf[i_])); asm volatile("" :: "v"(scale)); __syncthreads(); continue; }
        bf16x8_t pf[4];
#pragma unroll
        for (int pp = 0; pp < 4; ++pp) pf[pp] = __builtin_bit_cast(bf16x8_t, (v4u){pk2(sc[2 * pp][0], sc[2 * pp][1]), pk2(sc[2 * pp][2], sc[2 * pp][3]), pk2(sc[2 * pp + 1][0], sc[2 * pp + 1][1]), pk2(sc[2 * pp + 1][2], sc[2 * pp + 1][3])});
        v4u cpre[12];
        { const bf16* cp = cprev + (size_t)ch * 65536; const int piece = tid & 31;
#pragma unroll
          for (int i = 0; i < 12; ++i) { const int row = (tid >> 5) + 16 * i; cpre[i] = *(const GAS v4u*)(cp + (size_t)row * 256 + piece * 8); } }
        f32x4 o[16];
#pragma unroll
        for (int cb = 0; cb < 16; ++cb) o[cb] = (f32x4){0.f, 0.f, 0.f, 0.f};
#pragma unroll
        for (int pp = 0; pp < 4; ++pp) {
            if (2 * pp <= w) {
#pragma unroll
                for (int cb = 0; cb < 16; ++cb) { const bf16x8_t vf = tr_frag(L + ML_V, ML_PITCH, 32 * pp, 16 * cb, lane); o[cb] = __builtin_amdgcn_mfma_f32_16x16x32_bf16(pf[pp], vf, o[cb], 0, 0, 0); }
            }
        }
        if (MODE == 3) { _Pragma("unroll") for (int cb_ = 0; cb_ < 16; ++cb_) asm volatile("" :: "v"(o[cb_])); _Pragma("unroll") for (int i_ = 0; i_ < 12; ++i_) asm volatile("" :: "v"(cpre[i_])); __syncthreads(); continue; }
        __syncthreads();
        { const bf16* cp = cprev + (size_t)ch * 65536; const int piece = tid & 31; v4u late[4];
#pragma unroll
          for (int i = 0; i < 4; ++i) { const int row = (tid >> 5) + 16 * (12 + i); late[i] = *(const GAS v4u*)(cp + (size_t)row * 256 + piece * 8); }
#pragma unroll
          for (int i = 0; i < 12; ++i) { const int row = (tid >> 5) + 16 * i; *(LAS v4u*)(L + row * ML_PITCH + piece * 16) = cpre[i]; }
#pragma unroll
          for (int i = 0; i < 4; ++i) { const int row = (tid >> 5) + 16 * (12 + i); *(LAS v4u*)(L + row * ML_PITCH + piece * 16) = late[i]; } }
        __syncthreads();
#pragma unroll
        for (int ks = 0; ks < 8; ++ks) {
#pragma unroll
            for (int cb = 0; cb < 16; ++cb) { const bf16x8_t cf = tr_frag(L, ML_PITCH, 32 * ks, 16 * cb, lane); o[cb] = __builtin_amdgcn_mfma_f32_16x16x32_bf16(qf[ks], cf, o[cb], 0, 0, 0); }
        }
        if (MODE == 4) { _Pragma("unroll") for (int cb_ = 0; cb_ < 16; ++cb_) asm volatile("" :: "v"(o[cb_])); asm volatile("" :: "v"(scale)); __syncthreads(); continue; }
        __syncthreads();
        { LAS float* P = (LAS float*)(L + w * (16 * 260 * 4));
#pragma unroll
          for (int cb = 0; cb < 16; ++cb)
#pragma unroll
              for (int rg = 0; rg < 4; ++rg) P[(4 * g4 + rg) * 260 + 16 * cb + qa] = o[cb][rg];
          const size_t orow = row0 + 16 * w + qa; const int dv0 = 64 * g4;
          const GAS v4u* omp = (const GAS v4u*)(proj + orow * LDP + C_OM + hh * 256 + dv0);
          v4u omw[8];
#pragma unroll
          for (int i = 0; i < 8; ++i) omw[i] = omp[i];
          f32x4 val[16]; float ss = 0.f;
#pragma unroll
          for (int i = 0; i < 16; ++i) val[i] = *(const LAS f32x4*)(P + qa * 260 + dv0 + 4 * i);
#pragma unroll
          for (int i = 0; i < 8; ++i) { const unsigned ww[4] = {omw[i].x, omw[i].y, omw[i].z, omw[i].w};
#pragma unroll
              for (int k = 0; k < 4; ++k) { const float om0 = bflo(ww[k]), om1 = bfhi(ww[k]); f32x4& vv = val[2 * i + (k >> 1)]; const int c0 = 2 * (k & 1);
                  const float a0 = vv[c0] * scale * __builtin_amdgcn_rcpf(1.0f + __builtin_amdgcn_exp2f(-1.4426950408889634f * om0));
                  const float a1 = vv[c0 + 1] * scale * __builtin_amdgcn_rcpf(1.0f + __builtin_amdgcn_exp2f(-1.4426950408889634f * om1));
                  vv[c0] = a0; vv[c0 + 1] = a1; ss += a0 * a0 + a1 * a1; } }
          ss += __shfl_xor(ss, 16); ss += __shfl_xor(ss, 32);
          const float rs = rsqrtf(ss * (1.0f / 256.0f) + HN_EPS);
          const f32x4* bmp = (const f32x4*)(a.beta_m + hh * 256 + dv0);
          LAS unsigned char* Pb = (LAS unsigned char*)P;
#pragma unroll
          for (int i = 0; i < 8; ++i) { const f32x4 b0 = bmp[2 * i], b1 = bmp[2 * i + 1]; const f32x4 v0 = val[2 * i] * rs * b0, v1 = val[2 * i + 1] * rs * b1;
              v4u ow; ow.x = pk2(v0[0], v0[1]); ow.y = pk2(v0[2], v0[3]); ow.z = pk2(v1[0], v1[1]); ow.w = pk2(v1[2], v1[3]); *(LAS v4u*)(Pb + qa * 528 + 128 * g4 + 16 * i) = ow; }
#pragma unroll
          for (int i = 0; i < 8; ++i) { const int r = 2 * i + (lane >> 5), pc = lane & 31; const v4u ow = *(const LAS v4u*)(Pb + r * 528 + 16 * pc);
              *(GAS v4u*)(yb + (row0 + 16 * w + r) * LDY + 1024 + hh * 256 + 8 * pc) = ow; }
        }
        __syncthreads();
    }
}

__device__ __forceinline__ void p7_ln_router(Frame& F, const Args& a) {
    const bf16* z = (const bf16*)(a.ws + WS_Z); unsigned char* hb = a.ws + WS_HB; const float* rc = (const float*)(a.ws + WS_RC);
    unsigned* list = (unsigned*)(a.ws + WS_LIST); unsigned* tokinfo = (unsigned*)(a.ws + WS_TOKINFO);
    LAS float* lg = (LAS float*)(F.lds + RING_OFF);
    LAS unsigned* lcnt = (LAS unsigned*)(F.lds + RING_OFF + 16384); LAS unsigned* gbase = lcnt + 32;
    LAS float* st = (LAS float*)(F.lds + RING_OFF + 12288);
    const int lane = F.lane, w = F.wave;
    if (F.tid < 32) lcnt[F.tid] = 0u;
    LAS float* lnv = (LAS float*)(F.lds + RING_OFF + 32768);
    { const f32x4 t0 = ((const f32x4*)a.ln1_g)[F.tid], t1 = ((const f32x4*)a.ln1_b)[F.tid]; ((LAS f32x4*)lnv)[F.tid] = t0; ((LAS f32x4*)(lnv + DM))[F.tid] = t1; }
    __syncthreads();
    for (int grp = F.vcu; grp < NTOK / 64; grp += F.G) {
        const int base = grp * 64;
        for (int i = 0; i < 8; i += 2) {
            f32x4 v[2][8]; float s[2] = {0.f, 0.f};
#pragma unroll
            for (int r = 0; r < 2; ++r) { const GAS v2u* zr = (const GAS v2u*)(z + (size_t)(base + 8 * w + i + r) * LDX) + lane;
#pragma unroll
                for (int j = 0; j < 8; ++j) { const v2u zw = zr[64 * j]; v[r][j] = (f32x4){bflo(zw.x), bfhi(zw.x), bflo(zw.y), bfhi(zw.y)}; } }
#pragma unroll
            for (int r = 0; r < 2; ++r)
#pragma unroll
                for (int j = 0; j < 8; ++j) s[r] += (v[r][j].x + v[r][j].y) + (v[r][j].z + v[r][j].w);
            const float mean[2] = {wave_sum(s[0]) * (1.f / DM), wave_sum(s[1]) * (1.f / DM)}; float s2[2] = {0.f, 0.f};
#pragma unroll
            for (int r = 0; r < 2; ++r)
#pragma unroll
                for (int j = 0; j < 8; ++j) { v[r][j] = v[r][j] - mean[r]; s2[r] += (v[r][j].x * v[r][j].x + v[r][j].y * v[r][j].y) + (v[r][j].z * v[r][j].z + v[r][j].w * v[r][j].w); }
            const float rstd[2] = {rsqrtf(wave_sum(s2[0]) * (1.f / DM) + LN_EPS), rsqrtf(wave_sum(s2[1]) * (1.f / DM) + LN_EPS)};
            if (lane == 0) { *(LAS f32x4*)(st + 2 * (8 * w + i)) = (f32x4){mean[0], rstd[0], mean[1], rstd[1]}; }
#pragma unroll
            for (int j = 0; j < 8; ++j) { const f32x4 gg = *(const LAS f32x4*)(lnv + 256 * j + 4 * lane), bb = *(const LAS f32x4*)(lnv + DM + 256 * j + 4 * lane);
#pragma unroll
                for (int r = 0; r < 2; ++r) { const f32x4 hv = v[r][j] * rstd[r] * gg + bb;
                    ((GAS unsigned*)(hb + (size_t)(base + 8 * w + i + r) * LD8) + lane)[64 * j] = pg8::pk4_fp8(hv.x * 16.f, hv.y * 16.f, hv.z * 16.f, hv.w * 16.f); } }
        }
        __syncthreads();
        {
            const int qa = lane & 15, kq = lane >> 4;
            const bf16* wp = (const bf16*)(a.ws + WS_WRT) + (size_t)qa * DM + 256 * w + 8 * kq;
            bf16x8_t wf[2][2][8];
#pragma unroll
            for (int p = 0; p < 2; ++p)
#pragma unroll
                for (int eh = 0; eh < 2; ++eh)
#pragma unroll
                    for (int ks = 0; ks < 8; ++ks) wf[p][eh][ks] = *(const GAS bf16x8_t*)(wp + (size_t)p * NEXP * DM + (size_t)eh * 16 * DM + 32 * ks);
            LAS float* part = (LAS float*)(F.lds + RING_OFF + 49152);
#pragma unroll 1
            for (int rp = 0; rp < 4; ++rp) {
                constexpr int QB = 1;
                bf16x8_t zf[QB][8];
#pragma unroll
                for (int q = 0; q < QB; ++q)
#pragma unroll
                    for (int ks = 0; ks < 8; ++ks) zf[q][ks] = *(const GAS bf16x8_t*)(z + (size_t)(base + 16 * QB * rp + 16 * q + qa) * LDX + 256 * w + 32 * ks + 8 * kq);
#pragma unroll
                for (int q = 0; q < QB; ++q) {
                    f32x4 a0 = (f32x4){0.f, 0.f, 0.f, 0.f}, a1 = a0, c0 = a0, c1 = a0;
#pragma unroll
                    for (int ks = 0; ks < 8; ++ks) { a0 = __builtin_amdgcn_mfma_f32_16x16x32_bf16(zf[q][ks], wf[0][0][ks], a0, 0, 0, 0); a1 = __builtin_amdgcn_mfma_f32_16x16x32_bf16(zf[q][ks], wf[0][1][ks], a1, 0, 0, 0);
                        c0 = __builtin_amdgcn_mfma_f32_16x16x32_bf16(zf[q][ks], wf[1][0][ks], c0, 0, 0, 0); c1 = __builtin_amdgcn_mfma_f32_16x16x32_bf16(zf[q][ks], wf[1][1][ks], c1, 0, 0, 0); }
                    a0 = a0 + c0; a1 = a1 + c1;
#pragma unroll
                    for (int rg = 0; rg < 4; ++rg) { const int row = 16 * QB * rp + 16 * q + 4 * kq + rg; part[(w * 64 + row) * 33 + qa] = a0[rg]; part[(w * 64 + row) * 33 + 16 + qa] = a1[rg]; }
                }
            }
        }
        __syncthreads();
        {
            const int row = F.tid >> 3, e0 = (F.tid & 7) * 4; const float mu = st[2 * row], rs = st[2 * row + 1];
            const LAS float* part = (const LAS float*)(F.lds + RING_OFF + 49152);
#pragma unroll
            for (int j = 0; j < 4; ++j) { float sacc = 0.f;
#pragma unroll
                for (int ww = 0; ww < 8; ++ww) sacc += part[(ww * 64 + row) * 33 + e0 + j];
                lg[row * 33 + e0 + j] = rs * (sacc - mu * rc[e0 + j]) + rc[32 + e0 + j]; }
        }
        __syncthreads();
        int sel[4] = {0, 0, 0, 0}; unsigned lp[4] = {0u, 0u, 0u, 0u}; float gt[4] = {0.f, 0.f, 0.f, 0.f};
        if (w < 4) {
            if (lane < 16) {
                const LAS float* lr = lg + (w * 16 + lane) * 33;
                float sv[4];
#pragma unroll
                for (int k = 0; k < 4; ++k) { float best = -3.0e38f; int bi = 0;
                    for (int e = 0; e < 32; ++e) { const float x = lr[e]; const bool taken = (k > 0 && sel[0] == e) || (k > 1 && sel[1] == e) || (k > 2 && sel[2] == e); if (!taken && x > best) { best = x; bi = e; } }
                    sel[k] = bi; sv[k] = best; }
                const float e1 = __expf(sv[1] - sv[0]), e2 = __expf(sv[2] - sv[0]), e3 = __expf(sv[3] - sv[0]); const float inv = 1.0f / (1.0f + e1 + e2 + e3);
                gt[0] = inv; gt[1] = e1 * inv; gt[2] = e2 * inv; gt[3] = e3 * inv;
#pragma unroll
                for (int k = 0; k < 4; ++k) lp[k] = __hip_atomic_fetch_add(lcnt + sel[k], 1u, __ATOMIC_RELAXED, __HIP_MEMORY_SCOPE_WORKGROUP);
            }
        }
        __syncthreads();
        if (F.tid < 32) { const unsigned c = lcnt[F.tid]; gbase[F.tid] = c ? __hip_atomic_fetch_add((unsigned*)(F.ctl + CW_CNT + 64 * F.tid), c, RLX_AGENT) : 0u; lcnt[F.tid] = 0u; }
        __syncthreads();
        if (w < 4 && lane < 16) { const int m = base + 16 * w + lane;
#pragma unroll
            for (int k = 0; k < 4; ++k) { const unsigned pos = gbase[sel[k]] + lp[k]; list[(size_t)sel[k] * CAP + pos] = (unsigned)m;
                tokinfo[(size_t)m * 8 + 2 * k] = ((unsigned)sel[k] << 16) | pos; tokinfo[(size_t)m * 8 + 2 * k + 1] = __float_as_uint(gt[k]); } }
        __syncthreads();
    }
}

template <bool GATHER_> struct MoeOrder {
    static constexpr bool GATHER = GATHER_;
    const LAS int* tab; const unsigned* list; int NT, G, c, total;
    __device__ __forceinline__ bool next(int i, pg8::Unit& u) const {
        const int L = i * G + c; if (L >= total) return false;
        int e = 0;
#pragma unroll 8
        for (int k = 1; k < 32; ++k) e += (L >= tab[k] * NT) ? 1 : 0;
        e = __builtin_amdgcn_readfirstlane(e);
        const int t0 = __builtin_amdgcn_readfirstlane(tab[e]), nte = __builtin_amdgcn_readfirstlane(tab[e + 1]) - t0, q = L - t0 * NT, per = nte * 4, grp = q / per, rem = q - grp * per, ml = rem >> 2;
        u.pm = t0 + ml; u.pn = grp * 4 + (rem & 3); u.e = e; u.aux = ml * 256; return true;
    }
    __device__ __forceinline__ int btile(const pg8::Unit& u) const { return u.e * NT + u.pn; }
    __device__ __forceinline__ unsigned arow(const pg8::Unit& u, int r) const {
        const int pos = u.aux + r; const int cnt = tab[33 + u.e];
        const unsigned tok = (pos < cnt) ? list[(size_t)u.e * CAP + pos] : 0u;
        return tok * (unsigned)LD8;
    }
};
__device__ __forceinline__ void moe_tab(Frame& F) {
    LAS int* tab = (LAS int*)(F.lds + TAB_OFF);
    if (F.tid < 32) tab[33 + F.tid] = (int)__hip_atomic_load((unsigned*)(F.ctl + CW_CNT + 64 * F.tid), RLX_AGENT);
    __syncthreads();
    if (F.tid == 0) { int s = 0; for (int e = 0; e < 32; ++e) { tab[e] = s; int c = tab[33 + e]; if (c > CAP) c = CAP; s += (c + 255) >> 8; } if (s > MAXTILES) s = MAXTILES; tab[32] = s; }
    __syncthreads();
}

__device__ __forceinline__ void p9_final(Frame& F, const Args& a) {
    const bf16* z = (const bf16*)(a.ws + WS_Z); const unsigned char* ys = a.ws + WS_YS; const unsigned* tokinfo = (const unsigned*)(a.ws + WS_TOKINFO);
    const LAS int* tab = (const LAS int*)(F.lds + TAB_OFF);
    const int gw = F.vcu * NWAVES + F.wave, NGW = F.G * NWAVES, lane = F.lane;
    LAS float* lnv = (LAS float*)(F.lds + RING_OFF);
    { const f32x4 t2 = ((const f32x4*)a.ln2_g)[F.tid], t3 = ((const f32x4*)a.ln2_b)[F.tid]; ((LAS f32x4*)lnv)[F.tid] = t2; ((LAS f32x4*)(lnv + DM))[F.tid] = t3; }
    __syncthreads();
    for (int m0 = gw; m0 < NTOK; m0 += 2 * NGW) {
        const int mr[2] = {m0, (m0 + NGW < NTOK) ? m0 + NGW : m0};
        unsigned ti[2][8]; f32x4 v[2][8]; v2u zq[2][8]; unsigned yw[2][4][8]; float g16[2][4];
#pragma unroll
        for (int r = 0; r < 2; ++r) {
#pragma unroll
            for (int k = 0; k < 8; ++k) ti[r][k] = tokinfo[(size_t)mr[r] * 8 + k];
            const GAS v2u* zr = (const GAS v2u*)(z + (size_t)mr[r] * LDX) + lane;
#pragma unroll
            for (int j = 0; j < 8; ++j) zq[r][j] = zr[64 * j]; }
#pragma unroll
        for (int r = 0; r < 2; ++r)
#pragma unroll
            for (int k = 0; k < 4; ++k) { const unsigned ep = ti[r][2 * k]; g16[r][k] = __uint_as_float(ti[r][2 * k + 1]) * 0.0625f;
                const int e = (int)(ep >> 16), pos = (int)(ep & 0xffffu); const size_t slot = (size_t)tab[e] * 256 + pos;
                const GAS unsigned* yr = (const GAS unsigned*)(ys + slot * LD8) + lane;
#pragma unroll
                for (int j = 0; j < 8; ++j) yw[r][k][j] = yr[64 * j]; }
#pragma unroll
        for (int r = 0; r < 2; ++r) {
            {
                float s = 0.f;
#pragma unroll
                for (int j = 0; j < 8; ++j) { const v2u zw = zq[r][j]; v[r][j] = (f32x4){bflo(zw.x), bfhi(zw.x), bflo(zw.y), bfhi(zw.y)}; s += (v[r][j].x + v[r][j].y) + (v[r][j].z + v[r][j].w); }
                const float mean = wave_sum(s) * (1.f / DM); float s2 = 0.f;
#pragma unroll
                for (int j = 0; j < 8; ++j) { v[r][j] = v[r][j] - mean; s2 += (v[r][j].x * v[r][j].x + v[r][j].y * v[r][j].y) + (v[r][j].z * v[r][j].z + v[r][j].w * v[r][j].w); }
                const float rstd = rsqrtf(wave_sum(s2) * (1.f / DM) + LN_EPS);
#pragma unroll
                for (int j = 0; j < 8; ++j) { const f32x4 gg = *(const f32x4*)(a.ln1_g + 256 * j + 4 * lane), bb = *(const f32x4*)(a.ln1_b + 256 * j + 4 * lane); v[r][j] = (v[r][j] * rstd * gg + bb) * DN_ALPHA; }
            }
#pragma unroll
            for (int k = 0; k < 4; ++k)
#pragma unroll
                for (int j = 0; j < 8; ++j) { const unsigned w = yw[r][k][j]; const f32x2_ lo = __builtin_amdgcn_cvt_pk_f32_fp8(w, false), hi = __builtin_amdgcn_cvt_pk_f32_fp8(w, true); const float gq = g16[r][k];
                    v[r][j].x += gq * lo.x; v[r][j].y += gq * lo.y; v[r][j].z += gq * hi.x; v[r][j].w += gq * hi.y; }
            float s = 0.f;
#pragma unroll
            for (int j = 0; j < 8; ++j) s += (v[r][j].x + v[r][j].y) + (v[r][j].z + v[r][j].w);
            const float mean = wave_sum(s) * (1.f / DM); float s2 = 0.f;
#pragma unroll
            for (int j = 0; j < 8; ++j) { v[r][j] = v[r][j] - mean; s2 += (v[r][j].x * v[r][j].x + v[r][j].y * v[r][j].y) + (v[r][j].z * v[r][j].z + v[r][j].w * v[r][j].w); }
            const float rstd = rsqrtf(wave_sum(s2) * (1.f / DM) + LN_EPS);
            if (r == 0 || mr[1] != mr[0]) { GAS f32x4* o = (GAS f32x4*)(a.out + (size_t)mr[r] * DM) + lane;
#pragma unroll
                for (int j = 0; j < 8; ++j) { const f32x4 gg = *(const LAS f32x4*)(lnv + 256 * j + 4 * lane), bb = *(const LAS f32x4*)(lnv + DM + 256 * j + 4 * lane); o[64 * j] = v[r][j] * rstd * gg + bb; } }
        }
    }
}

__global__ void __launch_bounds__(NWAVES * 64, 2) hymba_fwd(Args args) {
    extern __shared__ __attribute__((aligned(16))) unsigned char lds[];
    Frame F;
    F.lds = (LAS unsigned char*)lds;
    F.MISC = (volatile LAS unsigned*)(F.lds + MISC_OFF);
    F.tid = threadIdx.x; F.lane = F.tid & 63; F.wave = __builtin_amdgcn_readfirstlane(F.tid >> 6);
    F.G = gridDim.x; { const int bx = blockIdx.x; F.vcu = (F.G % 8 == 0) ? (bx % 8) * (F.G / 8) + bx / 8 : bx; }
    F.ctl = (gu32*)(args.ws + WS_CTL);
    for (int u = F.tid; u < (LDS_BYTES - LDSCTL_OFF) / 4; u += NWAVES * 64) ((LAS unsigned*)(F.lds + LDSCTL_OFF))[u] = 0u;
    __syncthreads();
#if MK_ONE_LAUNCH
    XcdBarrier bar = xcd_barrier_post((unsigned*)(F.ctl + CW_BAR), F.MISC + 8);
#define GRID_BAR() xcd_barrier(bar)
#else
#define GRID_BAR() do { } while (0)
#endif
    const int lo = args.ph_lo, hi = args.ph_hi;
#define IN(k) (lo <= (k) && (k) < hi)
#define BOTH(k) (IN(k) && IN((k) + 1))
    unsigned char* ws = args.ws;

    if (IN(0)) for (int rep_ = 0; rep_ <= ((REP_MASK >> 0) & 1); ++rep_) { p0_prologue(F, args); if (BOTH(0) && rep_ == ((REP_MASK >> 0) & 1)) GRID_BAR(); }

    if (IN(1)) for (int rep_ = 0; rep_ <= ((REP_MASK >> 1) & 1); ++rep_) {
        const bool split = (F.G % 8 == 0) && (F.G >= 64);
        const int xg = (int)blockIdx.x & 7, xr = (int)blockIdx.x >> 3, per = F.G >> 3;
        {
            pg8::Gemm g{ws + WS_XB, ws + WS_WINT, DM * 2, LDX * 2, LDX * 2}; pg8::StaticOrder S;
            if (split) {
                constexpr int NG = 8 - XCONV;
                const int nblk = (NTOK / pg8::BM) * (NPROJ / pg8::BM) / per, nfull = (nblk / NG) * NG, left = nblk - nfull, give = (left <= XCONV && nblk * per == (NTOK / pg8::BM) * (NPROJ / pg8::BM)) ? left : 0;
                if (xg >= XCONV) { S.init(NTOK, NPROJ, per * NG, xr * NG + (xg - XCONV), NG); S.il = 1; S.lim = give ? nfull * per : S.nwg; }
                else { const int lb = XCONV - 1 - xg; S.init(NTOK, NPROJ, per, xr, 1); S.il = 1; S.base = (nfull + lb) * per; S.lim = lb < give ? S.base + per : 0; }
            } else S.init(NTOK, NPROJ, F.G, (int)blockIdx.x);
            pg8::EpiBf16Plain E{(bf16*)(ws + WS_PROJ), LDP};
            pg8::gemm_phase<pg8::EpiBf16Plain, pg8::StaticOrder>(F.lds + RING_OFF, g, S, E);
        }
        p1_convert_experts(F, args);
        if (BOTH(1) && rep_ == ((REP_MASK >> 1) & 1)) GRID_BAR();
    }
    if (IN(2)) for (int rep_ = 0; rep_ <= ((REP_MASK >> 2) & 1); ++rep_) { p2_conv(F, args);   }
    if (IN(3)) for (int rep_ = 0; rep_ <= ((REP_MASK >> 3) & 1); ++rep_) { p3_mlstm_local(F, args); p3_attn_mfma(F, args); if (BOTH(3) && rep_ == ((REP_MASK >> 3) & 1)) GRID_BAR(); }
    if (IN(4)) for (int rep_ = 0; rep_ <= ((REP_MASK >> 4) & 1); ++rep_) { p4_mlstm_scan(F, args); p4_attn_combine(F, args); if (BOTH(4) && rep_ == ((REP_MASK >> 4) & 1)) GRID_BAR(); }
    if (IN(5)) for (int rep_ = 0; rep_ <= ((REP_MASK >> 5) & 1); ++rep_) { p5_mlstm_out<0>(F, args);
#ifdef P5_PROBE_MODE
        p5_mlstm_out<P5_PROBE_MODE>(F, args);
#endif
        if (BOTH(5) && rep_ == ((REP_MASK >> 5) & 1)) GRID_BAR(); }
    if (IN(6)) for (int rep_ = 0; rep_ <= ((REP_MASK >> 6) & 1); ++rep_) {
        pg8::Gemm g{ws + WS_Y, ws + WS_WOUTT, DM * 2, LDY * 2, LDX * 2}; pg8::StaticOrder S; S.init(NTOK, DM, F.G, (int)blockIdx.x);
        pg8::EpiF32Res E{(bf16*)(ws + WS_Z), args.x, LDX, DM, DN_ALPHA};
        pg8::gemm_phase<pg8::EpiF32Res, pg8::StaticOrder>(F.lds + RING_OFF, g, S, E);
        if (BOTH(6) && rep_ == ((REP_MASK >> 6) & 1)) GRID_BAR();
    }
    if (IN(7)) for (int rep_ = 0; rep_ <= ((REP_MASK >> 7) & 1); ++rep_) { p7_ln_router(F, args); if (BOTH(7) && rep_ == ((REP_MASK >> 7) & 1)) GRID_BAR(); }
    if (IN(8)) for (int rep_ = 0; rep_ <= ((REP_MASK >> 8) & 1); ++rep_) {
        moe_tab(F);
        const LAS int* tab = (const LAS int*)(F.lds + TAB_OFF);
        MoeOrder<true> S{tab, (const unsigned*)(ws + WS_LIST), 16, F.G, F.vcu, __builtin_amdgcn_readfirstlane(tab[32]) * 16};
        pg8::Gemm g{ws + WS_HB, ws + WS_WUPT, DM, LD8, LD8};
        pg8::EpiSwiglu E{ws + WS_ACT, args.b_up, 4.0f, LD8};
        pg8::gemm_phase<pg8::EpiSwiglu, MoeOrder<true>, true, 0x7B7B7B7B, 0x79797979>(F.lds + RING_OFF, g, S, E);
        if (BOTH(8) && rep_ == ((REP_MASK >> 8) & 1)) GRID_BAR();
    }
    if (IN(9)) for (int rep_ = 0; rep_ <= ((REP_MASK >> 9) & 1); ++rep_) {
        moe_tab(F);
        const LAS int* tab = (const LAS int*)(F.lds + TAB_OFF);
        MoeOrder<false> S{tab, nullptr, 8, F.G, F.vcu, __builtin_amdgcn_readfirstlane(tab[32]) * 8};
        pg8::Gemm g{ws + WS_ACT, ws + WS_WDNT, DM, LD8, LD8};
        pg8::EpiBf16Bias E{ws + WS_YS, args.b_down, LD8};
        pg8::gemm_phase<pg8::EpiBf16Bias, MoeOrder<false>, true, 0x7D7D7D7D, 0x78787878>(F.lds + RING_OFF, g, S, E);
        if (BOTH(9) && rep_ == ((REP_MASK >> 9) & 1)) GRID_BAR();
    }
    if (IN(10)) for (int rep_ = 0; rep_ <= ((REP_MASK >> 10) & 1); ++rep_) { moe_tab(F); p9_final(F, args); }
#undef IN
#undef BOTH
}

extern "C" void kernel_launch(void* const* d_in, const int* in_sizes, int n_in, void* d_out, int out_size, void* d_ws, size_t ws_size, hipStream_t stream) {
    static int grid = 0;
    if (grid == 0) {
        if (n_in != 20 || in_sizes[0] != NTOK * DM || out_size != NTOK * DM || ws_size < WS_END) { fprintf(stderr, "kernel_launch: unexpected shapes (n_in %d, in0 %d, out %d, ws %zu < %zu); nothing launched\n", n_in, n_in > 0 ? in_sizes[0] : -1, out_size, ws_size, (size_t)WS_END); grid = -1; return; }
        int dev = 0, cus = 0, per_cu = 0;
        if (hipGetDevice(&dev) != hipSuccess || hipDeviceGetAttribute(&cus, hipDeviceAttributeMultiprocessorCount, dev) != hipSuccess) { grid = -1; return; }
        if (hipFuncSetAttribute((const void*)hymba_fwd, hipFuncAttributeMaxDynamicSharedMemorySize, LDS_BYTES) != hipSuccess) { fprintf(stderr, "kernel_launch: hipFuncSetAttribute failed\n"); grid = -1; return; }
        if (hipOccupancyMaxActiveBlocksPerMultiprocessor(&per_cu, (const void*)hymba_fwd, NWAVES * 64, LDS_BYTES) != hipSuccess || per_cu < 1)
            fprintf(stderr, "kernel_launch: note: occupancy query reports %d workgroups per CU\n", per_cu);
        (void)hipGetLastError();
        grid = cus;
    }
    if (grid < 0) return;
    if (hipMemsetAsync((char*)d_ws + WS_CTL, 0, CTL_ZERO_BYTES, stream) != hipSuccess) return;
    Args a{};
    a.x = (const float*)d_in[0]; a.w_in = (const float*)d_in[1]; a.b_ig = (const float*)d_in[2]; a.b_fg = (const float*)d_in[3]; a.conv_w = (const float*)d_in[4]; a.conv_b = (const float*)d_in[5];
    a.rel_bias = (const float*)d_in[6]; a.beta_a = (const float*)d_in[7]; a.beta_m = (const float*)d_in[8]; a.w_out = (const float*)d_in[9]; a.ln1_g = (const float*)d_in[10]; a.ln1_b = (const float*)d_in[11];
    a.w_router = (const float*)d_in[12]; a.b_router = (const float*)d_in[13]; a.w_up = (const float*)d_in[14]; a.b_up = (const float*)d_in[15]; a.w_down = (const float*)d_in[16]; a.b_down = (const float*)d_in[17];
    a.ln2_g = (const float*)d_in[18]; a.ln2_b = (const float*)d_in[19];
    a.out = (float*)d_out; a.ws = (unsigned char*)d_ws;
#if MK_ONE_LAUNCH
    a.ph_lo = 0; a.ph_hi = NPHASE;
    hipLaunchKernelGGL(hymba_fwd, dim3(grid), dim3(NWAVES * 64), LDS_BYTES, stream, a);
#else
    for (int p = 0; p < NPHASE; ++p) { a.ph_lo = p; a.ph_hi = p + 1; hipLaunchKernelGGL(hymba_fwd, dim3(grid), dim3(NWAVES * 64), LDS_BYTES, stream, a); }
#endif
}
```

```cpp
#include <hip/hip_runtime.h>
#include <cstdio>
#include <cstdint>

#define LDP_PAD 128
#ifndef REP_MASK
#define REP_MASK 0
#endif
#ifndef MK_ONE_LAUNCH
#define MK_ONE_LAUNCH 1
#endif

namespace pg8 {
#define PG8_LAS __attribute__((address_space(3)))
typedef unsigned short bf16_t;
typedef short bf16x8 __attribute__((ext_vector_type(8)));
typedef float f32x4 __attribute__((ext_vector_type(4)));
typedef float f32x2 __attribute__((ext_vector_type(2)));
typedef unsigned u32x4 __attribute__((ext_vector_type(4)));
constexpr int BM = 256, BK = 64, HALF = 128, HTB = HALF * BK * 2, STAGE_BYTES = 8 * HTB, NXCD = 8, WGM = 8;

__host__ __device__ __forceinline__ int lds_byte(int r, int c) { const int st = (r >> 4) * 2 + (c >> 5), rr = r & 15, cc = c & 31, ob = rr * 64 + cc * 2; return st * 1024 + (ob ^ (((ob >> 9) & 1) << 5)); }
__host__ __device__ __forceinline__ void stage_rc(int b, int& R, int& C) { const int st = b / 1024, sb = b % 1024, swz = sb ^ (((sb >> 9) & 1) << 5); R = (st >> 1) * 16 + swz / 64; C = (st & 1) * 32 + (swz % 64) / 2; }
__host__ __device__ __forceinline__ int perm32(int rho) { const int n = rho >> 4, i = rho & 15; return 8 * (i >> 2) + 4 * n + (i & 3); }

struct Unit { int pm, pn, e, aux; };
struct Gemm { const void* A; const void* Bt; int kb, lda, ldb; };
typedef int i32x8 __attribute__((ext_vector_type(8)));
typedef int i32x4 __attribute__((ext_vector_type(4)));

struct StaticOrder {
    static constexpr bool GATHER = false;
    int nM, nN, nwg, G, c, nx, il, base, lim;
    __device__ void init(int M, int N, int G_, int c_, int nx_ = NXCD) { nM = M / BM; nN = N / BM; nwg = nM * nN; G = G_; c = c_; nx = nx_; il = 0; base = 0; lim = nwg; }
    __device__ bool next(int i, Unit& u) const {
        const long L = (long)i * G + c; if (!il && L >= nwg) return false;
        int wgid = (int)L;
        if (il) {
            const int px = G / nx, xcd = wgid % nx, off = wgid / nx; wgid = base + ((off / px) * nx + xcd) * px + (off % px); if (wgid >= lim) return false;
        } else { const int q = nwg / nx, r = nwg % nx, xcd = wgid % nx, off = wgid / nx; wgid = (xcd < r ? xcd * (q + 1) : r * (q + 1) + (xcd - r) * q) + off; }
        const int nig = WGM * nN, gid = wgid / nig, fm = gid * WGM, gsz = (nM - fm) < WGM ? (nM - fm) : WGM;
        u.pm = fm + ((wgid % nig) % gsz); u.pn = (wgid % nig) / gsz; u.e = 0; u.aux = 0; return true;
    }
    __device__ __forceinline__ int btile(const Unit& u) const { return u.pn; }
    __device__ __forceinline__ unsigned arow(const Unit&, int) const { return 0u; }
};

__device__ __forceinline__ unsigned cvt_pk_bf16(float lo, float hi) { unsigned r; asm volatile("v_cvt_pk_bf16_f32 %0, %1, %2" : "=v"(r) : "v"(lo), "v"(hi)); return r; }

struct EpiBf16Plain {
    static constexpr bool PERM = true;
    bf16_t* O; int ldc;
    __device__ __forceinline__ void operator()(const f32x4 (&acc)[2][2][4][2], const Unit& u, int wr, int wc, int fr, int fq) const {
        const int row0 = u.pm * BM + wr * 64 + fr, col0 = u.pn * BM + wc * 32 + 8 * fq;
#pragma unroll
        for (int ai = 0; ai < 2; ++ai)
#pragma unroll
            for (int m = 0; m < 4; ++m) { bf16_t* rowp = O + (size_t)(row0 + ai * HALF + m * 16) * ldc + col0;
#pragma unroll
                for (int bj = 0; bj < 2; ++bj) { const f32x4 v0 = acc[ai][bj][m][0], v1 = acc[ai][bj][m][1];
                    u32x4 w; w.x = cvt_pk_bf16(v0[0], v0[1]); w.y = cvt_pk_bf16(v0[2], v0[3]); w.z = cvt_pk_bf16(v1[0], v1[1]); w.w = cvt_pk_bf16(v1[2], v1[3]);
                    *(u32x4*)(rowp + bj * HALF) = w; } }
    }
};
struct EpiF32Res {
    static constexpr bool PERM = true;
    bf16_t* O; const float* X; int ldc, ldx; float alpha;
    __device__ __forceinline__ void operator()(const f32x4 (&acc)[2][2][4][2], const Unit& u, int wr, int wc, int fr, int fq) const {
        const int col0 = u.pn * BM + wc * 32 + 8 * fq;
#pragma unroll
        for (int ai = 0; ai < 2; ++ai)
#pragma unroll
            for (int m = 0; m < 4; ++m) { const size_t rowi = (size_t)(u.pm * BM + ai * HALF + wr * 64 + m * 16 + fr), off = rowi * ldc + col0, offx = rowi * ldx + col0;
#pragma unroll
                for (int bj = 0; bj < 2; ++bj) { const f32x4 x0 = *(const f32x4*)(X + offx + bj * HALF), x1 = *(const f32x4*)(X + offx + bj * HALF + 4);
                    const f32x4 v0 = acc[ai][bj][m][0] + x0 * alpha, v1 = acc[ai][bj][m][1] + x1 * alpha;
                    u32x4 w; w.x = cvt_pk_bf16(v0[0], v0[1]); w.y = cvt_pk_bf16(v0[2], v0[3]); w.z = cvt_pk_bf16(v1[0], v1[1]); w.w = cvt_pk_bf16(v1[2], v1[3]);
                    *(u32x4*)(O + off + bj * HALF) = w; } }
    }
};
__device__ __forceinline__ unsigned pk4_fp8(float a, float b, float c, float d) {
    a = fminf(fmaxf(a, -448.f), 448.f); b = fminf(fmaxf(b, -448.f), 448.f); c = fminf(fmaxf(c, -448.f), 448.f); d = fminf(fmaxf(d, -448.f), 448.f);
    unsigned w = 0u; w = __builtin_amdgcn_cvt_pk_fp8_f32(a, b, w, false); w = __builtin_amdgcn_cvt_pk_fp8_f32(c, d, w, true); return w;
}
struct EpiSwiglu {
    static constexpr bool PERM = true;
    unsigned char* O; const float* bup; float oscale; int ldo;
    __device__ __forceinline__ void pack(const f32x4 (&acc)[2][2][4][2], int ai, int m, const f32x4& g0, const f32x4& g1, const f32x4& u0, const f32x4& u1, unsigned& w0, unsigned& w1) const {
        float r[8];
#pragma unroll
        for (int n = 0; n < 2; ++n) { const f32x4 gv = acc[ai][0][m][n] + (n ? g1 : g0), uv = acc[ai][1][m][n] + (n ? u1 : u0);
            f32x4 gate, up;
#pragma unroll
            for (int j = 0; j < 4; ++j) { gate[j] = fminf(gv[j], 7.0f); up[j] = fminf(fmaxf(uv[j], -7.0f), 7.0f); }
            const f32x4 t = gate * -2.4554669595930157f;
            f32x4 d;
#pragma unroll
            for (int j = 0; j < 4; ++j) d[j] = __builtin_amdgcn_exp2f(t[j]);
            d = d + 1.0f;
            f32x4 sg;
#pragma unroll
            for (int j = 0; j < 4; ++j) sg[j] = __builtin_amdgcn_rcpf(d[j]);
            const f32x4 rr = (up * oscale + oscale) * (gate * sg);
#pragma unroll
            for (int j = 0; j < 4; ++j) r[n * 4 + j] = rr[j]; }
        w0 = 0u; w1 = 0u;
        w0 = __builtin_amdgcn_cvt_pk_fp8_f32(r[0], r[1], w0, false); w0 = __builtin_amdgcn_cvt_pk_fp8_f32(r[2], r[3], w0, true);
        w1 = __builtin_amdgcn_cvt_pk_fp8_f32(r[4], r[5], w1, false); w1 = __builtin_amdgcn_cvt_pk_fp8_f32(r[6], r[7], w1, true);
    }
    __device__ __forceinline__ void operator()(const f32x4 (&acc)[2][2][4][2], const Unit& u, int wr, int wc, int fr, int fq) const {
        const int row0 = u.pm * BM + wr * 64 + fr, c0 = u.pn * HALF + wc * 32 + 8 * fq;
        const float* bg = bup + (size_t)u.e * 4096 + c0; const float* bu = bg + 2048;
        const f32x4 g0 = *(const f32x4*)bg, g1 = *(const f32x4*)(bg + 4), u0 = *(const f32x4*)bu, u1 = *(const f32x4*)(bu + 4);
        const int odd = fq & 1; unsigned char* base = O + (size_t)(row0 + odd * 16) * ldo + (c0 - 8 * odd);
#pragma unroll
        for (int ai = 0; ai < 2; ++ai)
#pragma unroll
            for (int m = 0; m < 4; m += 2) { unsigned a0, a1, b0, b1; pack(acc, ai, m, g0, g1, u0, u1, a0, a1); pack(acc, ai, m + 1, g0, g1, u0, u1, b0, b1);
                const auto rx = __builtin_amdgcn_permlane16_swap(a0, b0, false, false), ry = __builtin_amdgcn_permlane16_swap(a1, b1, false, false);
                u32x4 st; st.x = rx[0]; st.y = ry[0]; st.z = rx[1]; st.w = ry[1];
                *(u32x4*)(base + (size_t)(ai * HALF + m * 16) * ldo) = st; }
    }
};
struct EpiBf16Bias {
    static constexpr bool PERM = true;
    unsigned char* O; const float* bdn; int ldo;
    __device__ __forceinline__ void operator()(const f32x4 (&acc)[2][2][4][2], const Unit& u, int wr, int wc, int fr, int fq) const {
        const int row0 = u.pm * BM + wr * 64 + fr, col0 = u.pn * BM + wc * 32 + 8 * fq;
        const float* bp = bdn + (size_t)u.e * 2048 + col0;
        f32x4 bv[2][2];
#pragma unroll
        for (int bj = 0; bj < 2; ++bj)
#pragma unroll
            for (int n = 0; n < 2; ++n) bv[bj][n] = *(const f32x4*)(bp + bj * HALF + 4 * n) * 16.0f;
        const int odd = fq & 1; unsigned char* base = O + (size_t)(row0 + odd * 16) * ldo + (col0 - 8 * odd);
#pragma unroll
        for (int ai = 0; ai < 2; ++ai)
#pragma unroll
            for (int m = 0; m < 4; m += 2)
#pragma unroll
                for (int bj = 0; bj < 2; ++bj) {
                    const f32x4 p0 = acc[ai][bj][m][0] * 16.0f + bv[bj][0], p1 = acc[ai][bj][m][1] * 16.0f + bv[bj][1], q0 = acc[ai][bj][m + 1][0] * 16.0f + bv[bj][0], q1 = acc[ai][bj][m + 1][1] * 16.0f + bv[bj][1];
                    const auto rx = __builtin_amdgcn_permlane16_swap(pk4_fp8(p0[0], p0[1], p0[2], p0[3]), pk4_fp8(q0[0], q0[1], q0[2], q0[3]), false, false);
                    const auto ry = __builtin_amdgcn_permlane16_swap(pk4_fp8(p1[0], p1[1], p1[2], p1[3]), pk4_fp8(q1[0], q1[1], q1[2], q1[3]), false, false);
                    u32x4 st; st.x = rx[0]; st.y = ry[0]; st.z = rx[1]; st.w = ry[1];
                    *(u32x4*)(base + (size_t)(ai * HALF + m * 16) * ldo + bj * HALF) = st; }
    }
};

typedef double f64x2 __attribute__((ext_vector_type(2)));
__device__ __forceinline__ f32x4 zero128() { double z0, z1; asm volatile("v_mov_b64 %0, 0\n\tv_mov_b64 %1, 0" : "=v"(z0), "=v"(z1)); return __builtin_bit_cast(f32x4, (f64x2){z0, z1}); }
template <class Epi, class Sched, bool FP8 = false, int SCA = 0x7F7F7F7F, int SCB = 0x7F7F7F7F>
__device__ __forceinline__ void gemm_phase(PG8_LAS unsigned char* lds, const Gemm g, const Sched& S, const Epi& E) {
    constexpr bool GATHER = Sched::GATHER;
    const int tid = threadIdx.x, wid = __builtin_amdgcn_readfirstlane(tid >> 6), lane = tid & 63, wr = wid >> 2, wc = wid & 3, fr = lane & 15, fq = lane >> 4;
    const int lda = g.lda, ldb = g.ldb, nt = g.kb / (BK * 2);
    unsigned voffA[2], voffB[2]; int RA[2], CA[2];
#pragma unroll
    for (int i = 0; i < 2; ++i) { int R, C; stage_rc(tid * 16 + i * 8192, R, C); const int Rb = Epi::PERM ? ((R & ~31) + perm32(R & 31)) : R; RA[i] = R; CA[i] = C;
        voffA[i] = (unsigned)(R * lda + C * 2); voffB[i] = (unsigned)(Rb * ldb + C * 2); }
    const size_t kstep = (size_t)(BK * 2);
    const size_t hstepA = (size_t)HALF * lda, hstep = (size_t)HALF * ldb;
    const size_t tstep = 2 * hstep, tstepA = 2 * hstepA;
    const unsigned ldsw = (unsigned)wid * 1024u;
    const unsigned lds0 = (unsigned)__builtin_amdgcn_readfirstlane((int)((unsigned)(size_t)lds + ldsw));
    const int aoff = lds_byte(wr * 64 + fr, fq * 8), boff = lds_byte(wc * 32 + fr, fq * 8);
    const int a8o0 = lds_byte(wr * 64 + fr, 16 * fq + 8 * (fq & 1)), b8o0 = lds_byte(wc * 32 + fr, 16 * fq + 8 * (fq & 1));
#define a8o1 (a8o0 ^ 16)
#define b8o1 (b8o0 ^ 16)
#define PG8_SA(b, h) (((b) * 2 + (h)) * HTB)
#define PG8_SB(b, h) ((4 + (b) * 2 + (h)) * HTB)
#define PG8_STAGE(bufoff, gbase, voff) do { _Pragma("unroll") for (int _i = 0; _i < 2; ++_i) { unsigned _keep; \
        asm volatile("s_mov_b32 %0, m0\n\ts_mov_b32 m0, %3\n\ts_nop 0\n\tglobal_load_lds_dwordx4 %1, %2\n\ts_mov_b32 m0, %0" : "=&s"(_keep) : "v"((voff)[_i]), "s"((const char*)(gbase)), "s"(lds0 + (unsigned)((bufoff) + _i * 8192)) : "memory"); } } while (0)
#define PG8_STAGE_AC(bufoff, base, h) do { if constexpr (GATHER) PG8_STAGE(bufoff, base, vc[h]); else PG8_STAGE(bufoff, (base) + (h) * hstepA, voffA); } while (0)
#define PG8_STAGE_AS(bufoff, base, h) do { if constexpr (GATHER) PG8_STAGE(bufoff, base, s2[h]); else PG8_STAGE(bufoff, (base) + (h) * hstepA, voffA); } while (0)
#define PG8_Q8(p0, p1) ({ const i32x4 _lo = *(const PG8_LAS i32x4*)(p0), _hi = *(const PG8_LAS i32x4*)(p1); (i32x8){_lo[0], _lo[1], _lo[2], _lo[3], _hi[0], _hi[1], _hi[2], _hi[3]}; })
#define PG8_LDA(dst, b, h) do { if constexpr (FP8) { _Pragma("unroll") for (int m = 0; m < 4; ++m) Aq[m] = PG8_Q8(lds + PG8_SA(b, h) + a8o0 + m * 2048, lds + PG8_SA(b, h) + a8o1 + m * 2048); } \
        else { _Pragma("unroll") for (int m = 0; m < 4; ++m) _Pragma("unroll") for (int k = 0; k < 2; ++k) dst[m][k] = *(const PG8_LAS bf16x8*)(lds + PG8_SA(b, h) + aoff + m * 2048 + k * 1024); } } while (0)
#define PG8_LDB(dst, b, h) do { if constexpr (FP8) { _Pragma("unroll") for (int n = 0; n < 2; ++n) dst##q[n] = PG8_Q8(lds + PG8_SB(b, h) + b8o0 + n * 2048, lds + PG8_SB(b, h) + b8o1 + n * 2048); } \
        else { _Pragma("unroll") for (int n = 0; n < 2; ++n) _Pragma("unroll") for (int k = 0; k < 2; ++k) dst[n][k] = *(const PG8_LAS bf16x8*)(lds + PG8_SB(b, h) + boff + n * 2048 + k * 1024); } } while (0)
#define PG8_MMA(ai, bj, At, Bt) do { __builtin_amdgcn_s_setprio(1); if constexpr (FP8) { _Pragma("unroll") for (int m = 0; m < 4; ++m) _Pragma("unroll") for (int n = 0; n < 2; ++n) \
        asm volatile("v_mfma_scale_f32_16x16x128_f8f6f4 %0, %1, %2, %0, %3, %4 op_sel_hi:[0,0,0]" : "+v"(acc[ai][bj][m][n]) : "v"(Bt##q[n]), "v"(Aq[m]), "v"(scb_), "v"(sca_)); } \
        else { _Pragma("unroll") for (int m = 0; m < 4; ++m) _Pragma("unroll") for (int n = 0; n < 2; ++n) _Pragma("unroll") for (int k = 0; k < 2; ++k) \
        acc[ai][bj][m][n] = __builtin_amdgcn_mfma_f32_16x16x32_bf16(Bt[n][k], At[m][k], acc[ai][bj][m][n], 0, 0, 0); } __builtin_amdgcn_s_setprio(0); } while (0)
#define PG8_WAIT_V(n) asm volatile("s_waitcnt vmcnt(" #n ")" ::: "memory")
#define PG8_WAIT_L(n) asm volatile("s_waitcnt lgkmcnt(" #n ")" ::: "memory")
#define PG8_BAR __builtin_amdgcn_s_barrier()
#define PG8_SCHED __builtin_amdgcn_sched_barrier(0)
    Unit cur, nxt; int ui = 0;
    if (!S.next(0, cur)) return;
    f32x4 acc[2][2][4][2];
#pragma unroll
    for (int a = 0; a < 2; ++a)
#pragma unroll
        for (int b = 0; b < 2; ++b)
#pragma unroll
            for (int m = 0; m < 4; ++m)
#pragma unroll
                for (int n = 0; n < 2; ++n) acc[a][b][m][n] = zero128();
    bf16x8 At[4][2], B0[2][2], B1[2][2]; i32x8 Aq[4], B0q[2], B1q[2];
    int sca_ = SCA, scb_ = SCB; asm volatile("" : "+v"(sca_), "+v"(scb_));
    unsigned vc[2][2], vn[2][2];
    if constexpr (GATHER) {
#pragma unroll
        for (int h = 0; h < 2; ++h)
#pragma unroll
            for (int i = 0; i < 2; ++i) { vc[h][i] = S.arow(cur, h * HALF + RA[i]) + (unsigned)CA[i] * 2u; vn[h][i] = vc[h][i]; }
    } else {
#pragma unroll
        for (int h = 0; h < 2; ++h)
#pragma unroll
            for (int i = 0; i < 2; ++i) { vc[h][i] = 0u; vn[h][i] = 0u; }
    }
    const char* cA = GATHER ? (const char*)g.A : (const char*)g.A + (size_t)cur.pm * tstepA; const char* cB = (const char*)g.Bt + (size_t)S.btile(cur) * tstep;
    PG8_STAGE(PG8_SB(0, 0), cB, voffB); PG8_STAGE(PG8_SB(0, 1), cB + hstep, voffB); PG8_STAGE_AC(PG8_SA(0, 0), cA, 0); PG8_STAGE_AC(PG8_SA(0, 1), cA, 1);
    if (wr == 1) PG8_BAR;
    PG8_WAIT_V(2); PG8_BAR;
    PG8_STAGE(PG8_SB(1, 0), cB + kstep, voffB); PG8_STAGE_AC(PG8_SA(1, 0), cA + kstep, 0); PG8_STAGE(PG8_SB(1, 1), cB + hstep + kstep, voffB);
    PG8_WAIT_V(6); PG8_BAR;
    for (;;) {
        const bool has_next = S.next(ui + 1, nxt);
        const char* nA = has_next ? (GATHER ? (const char*)g.A : (const char*)g.A + (size_t)nxt.pm * tstepA) : cA; const char* nB = has_next ? (const char*)g.Bt + (size_t)S.btile(nxt) * tstep : cB;
        if constexpr (GATHER) { if (has_next) {
#pragma unroll
            for (int h = 0; h < 2; ++h)
#pragma unroll
                for (int i = 0; i < 2; ++i) vn[h][i] = S.arow(nxt, h * HALF + RA[i]) + (unsigned)CA[i] * 2u; } }
        for (int t = 0; t < nt; t += 2) {
            const bool last = (t == nt - 2);
            const char* a1 = cA + (size_t)(t + 1) * kstep;
            const char* a2 = last ? nA : cA + (size_t)(t + 2) * kstep; const char* b2 = last ? nB : cB + (size_t)(t + 2) * kstep;
            const char* a3 = a2 + kstep; const char* b3 = b2 + kstep;
            unsigned s2[2][2];
#pragma unroll
            for (int h = 0; h < 2; ++h)
#pragma unroll
                for (int i = 0; i < 2; ++i) s2[h][i] = (GATHER && last) ? vn[h][i] : vc[h][i];
            PG8_LDB(B0, 0, 0); PG8_LDB(B1, 0, 1); PG8_SCHED; PG8_LDA(At, 0, 0); PG8_STAGE_AC(PG8_SA(1, 1), a1, 1);
            PG8_WAIT_V(8); PG8_WAIT_L(0); PG8_BAR; PG8_MMA(0, 0, At, B0); PG8_MMA(0, 1, At, B1); PG8_BAR; PG8_SCHED;
            PG8_LDA(At, 0, 1); PG8_STAGE(PG8_SB(0, 0), b2, voffB); PG8_STAGE(PG8_SB(0, 1), b2 + hstep, voffB); PG8_STAGE_AS(PG8_SA(0, 0), a2, 0);
            PG8_WAIT_V(8); PG8_WAIT_L(0); PG8_BAR; PG8_MMA(1, 0, At, B0); PG8_MMA(1, 1, At, B1); PG8_BAR; PG8_SCHED;
            PG8_LDB(B0, 1, 0); PG8_LDB(B1, 1, 1); PG8_SCHED; PG8_LDA(At, 1, 0); PG8_STAGE_AS(PG8_SA(0, 1), a2, 1);
            PG8_WAIT_V(8); PG8_WAIT_L(0); PG8_BAR; PG8_MMA(0, 0, At, B0); PG8_MMA(0, 1, At, B1); PG8_BAR; PG8_SCHED;
            PG8_LDA(At, 1, 1); PG8_STAGE(PG8_SB(1, 0), b3, voffB); PG8_STAGE(PG8_SB(1, 1), b3 + hstep, voffB); PG8_STAGE_AS(PG8_SA(1, 0), a3, 0);
            PG8_WAIT_V(8); PG8_WAIT_L(0); PG8_BAR; PG8_MMA(1, 0, At, B0); PG8_MMA(1, 1, At, B1); PG8_BAR; PG8_SCHED;
        }
        if (wr == 0) PG8_BAR;
        if constexpr (FP8) asm volatile("s_nop 15\n\ts_nop 15" ::: "memory");
        { int l2 = (int)__builtin_amdgcn_mbcnt_hi(~0u, __builtin_amdgcn_mbcnt_lo(~0u, 0u)); asm volatile("" : "+v"(l2));
          E(acc, cur, wr, wc, l2 & 15, l2 >> 4); }
        if (!has_next) break;
#pragma unroll
        for (int a = 0; a < 2; ++a)
#pragma unroll
            for (int b = 0; b < 2; ++b)
#pragma unroll
                for (int m = 0; m < 4; ++m)
#pragma unroll
                    for (int n = 0; n < 2; ++n) acc[a][b][m][n] = zero128();
        cur = nxt; cA = nA; cB = nB; ++ui;
        if constexpr (GATHER) {
#pragma unroll
            for (int h = 0; h < 2; ++h)
#pragma unroll
                for (int i = 0; i < 2; ++i) vc[h][i] = vn[h][i]; }
        if (wr == 1) PG8_BAR;
    }
    PG8_WAIT_V(0);
    PG8_BAR;
#undef PG8_SA
#undef PG8_SB
#undef PG8_STAGE
#undef PG8_STAGE_AC
#undef PG8_STAGE_AS
#undef PG8_LDA
#undef PG8_Q8
#undef a8o1
#undef b8o1
#undef PG8_LDB
#undef PG8_MMA
#undef PG8_WAIT_V
#undef PG8_WAIT_L
#undef PG8_BAR
#undef PG8_SCHED
}
}

constexpr int NWAVES = 8;
constexpr int BATCH = 2, SEQ = 8192, NTOK = BATCH * SEQ, DM = 2048;
constexpr int NPROJ = 7168, INCOLS = 7176;
constexpr int C_QA = 0, C_KA = 1024, C_VA = 2048, C_QM = 3072, C_KM = 4096, C_VM = 5120, C_OM = 6144;
constexpr int NHA = 16, NHM = 4, DHM = 256;
constexpr int NEXP = 32, TOPK = 4, CAP = NTOK, MAXTILES = 288, NSLOT = MAXTILES * 256;
constexpr float DN_ALPHA = 1.189207115002721f;
constexpr float LN_EPS = 1e-5f, HN_EPS = 1e-6f;
constexpr int NPHASE = 11;
#ifndef XCONV
#define XCONV 3
#endif
#ifndef NCONV
#define NCONV 96
#endif
constexpr int LDX = DM;
#ifndef LDQ_PAD
#define LDQ_PAD 0
#endif
#ifndef LDP_PAD
#define LDP_PAD 0
#endif
#ifndef LDOG_PAD
#define LDOG_PAD 0
#endif
constexpr int LDQ = DM + LDQ_PAD;
constexpr int LDY = DM + 128;
constexpr int LDP = NPROJ + LDP_PAD;
constexpr int LDH = DM;
constexpr int LD8 = DM;
constexpr int LDOG = 1024 + LDOG_PAD;

constexpr size_t MiB = 1u << 20;
constexpr size_t WS_CTL = 0, CTL_ZERO_BYTES = 64 * 1024;
constexpr size_t WS_GATES = 1 * MiB;
constexpr size_t WS_BIAS = 1 * MiB + 512 * 1024;
constexpr size_t WS_TOKINFO = 2 * MiB;
constexpr size_t WS_LIST = 3 * MiB;
constexpr size_t WS_BCUM = 5 * MiB;
constexpr size_t WS_UCOL = WS_BCUM + 512 * 128 * 4;
constexpr size_t WS_CHS = WS_UCOL + 512 * 128 * 4;
constexpr size_t WS_NLOC = 6 * MiB;
constexpr size_t WS_NPREV = WS_NLOC + 512 * 256 * 4;
constexpr size_t WS_WRT = 7 * MiB;
constexpr size_t WS_RC = WS_WRT + 512 * 1024;
constexpr size_t WS_LSE = 8 * MiB;
constexpr size_t ws_up(size_t b) { return (b + MiB - 1) / MiB * MiB; }
constexpr size_t WS_WINT = 12 * MiB;
constexpr size_t WS_WOUTT = WS_WINT + ws_up((size_t)NPROJ * LDX * 2);
constexpr size_t WS_XB = WS_WOUTT + ws_up((size_t)DM * LDX * 2);
constexpr size_t WS_PROJ = WS_XB + ws_up((size_t)NTOK * LDX * 2);
constexpr size_t WS_QKM = WS_PROJ + ws_up((size_t)NTOK * LDP * 2);
constexpr size_t WS_Y = WS_QKM + ws_up((size_t)NTOK * LDQ * 2);
constexpr size_t WS_Z = WS_Y + ws_up((size_t)NTOK * LDY * 2);
constexpr size_t WS_H = WS_Z + ws_up((size_t)NTOK * LDX * 2);
constexpr size_t WS_HB = WS_H + ws_up((size_t)NTOK * LDH * 4);
constexpr size_t WS_ACT = WS_HB + ws_up((size_t)NTOK * LD8);
constexpr size_t WS_YS = WS_ACT + ws_up((size_t)NSLOT * LD8);
constexpr size_t WS_WUPT = WS_YS + ws_up((size_t)NSLOT * LD8);
constexpr size_t WS_WDNT = WS_WUPT + ws_up((size_t)NEXP * 4096 * LD8);
constexpr size_t WS_OG = WS_WDNT + ws_up((size_t)NEXP * DM * LD8);
constexpr size_t WS_CLOC = WS_OG + ws_up((size_t)3 * NTOK * LDOG * 2);
constexpr size_t WS_CPREV = WS_CLOC + 64 * MiB;
constexpr size_t WS_END = WS_CPREV + 64 * MiB;
constexpr int CW_TMO = 0, CW_CODE = 1;
constexpr int CW_BAR = 4096;
constexpr int CW_CONV = 12288;
constexpr int CW_CNT = 8192;

constexpr int RING_OFF = 0, RING_BYTES = 131072;
constexpr int SCR_BYTES = 151552;
constexpr int LDSCTL_OFF = SCR_BYTES, MISC_OFF = LDSCTL_OFF + 320;
constexpr int TAB_OFF = LDSCTL_OFF + 1024;
constexpr int LDS_BYTES = 155648;

#define GAS __attribute__((address_space(1)))
#define LAS __attribute__((address_space(3)))
typedef unsigned short bf16;
typedef unsigned v4u __attribute__((ext_vector_type(4)));
typedef unsigned v2u __attribute__((ext_vector_type(2)));
typedef float f32x4 __attribute__((ext_vector_type(4)));
typedef float f32x2_ __attribute__((ext_vector_type(2)));
typedef GAS unsigned gu32;
#define RLX_AGENT __ATOMIC_RELAXED, __HIP_MEMORY_SCOPE_AGENT
#define LDS_WAIT() asm volatile("s_waitcnt lgkmcnt(0)" ::: "memory")
#define VM_WAIT() asm volatile("s_waitcnt vmcnt(0)" ::: "memory")
typedef float f32x2p __attribute__((ext_vector_type(2))); typedef __bf16 bf16x2p __attribute__((ext_vector_type(2)));
__device__ __forceinline__ unsigned pk2(float lo, float hi) { const f32x2p v = {lo, hi}; return __builtin_bit_cast(unsigned, __builtin_convertvector(v, bf16x2p)); }
__device__ __forceinline__ unsigned f2bf(float f) { return pk2(f, 0.f) & 0xffffu; }
__device__ __forceinline__ float bflo(unsigned w) { return __uint_as_float(w << 16); }
__device__ __forceinline__ float bfhi(unsigned w) { return __uint_as_float(w & 0xffff0000u); }
__device__ __forceinline__ float bf1(bf16 b) { return __uint_as_float((unsigned)b << 16); }
template <int CTRL> __device__ __forceinline__ float dpp_f(float v) { return __int_as_float(__builtin_amdgcn_update_dpp(0, __float_as_int(v), CTRL, 0xF, 0xF, true)); }
__device__ __forceinline__ float xor16_sum(float v) { const auto r = __builtin_amdgcn_permlane16_swap(__float_as_uint(v), __float_as_uint(v), false, false); return __uint_as_float(r[0]) + __uint_as_float(r[1]); }
__device__ __forceinline__ float xor32_sum(float v) { const auto r = __builtin_amdgcn_permlane32_swap(__float_as_uint(v), __float_as_uint(v), false, false); return __uint_as_float(r[0]) + __uint_as_float(r[1]); }
__device__ __forceinline__ float xor16_max(float v) { const auto r = __builtin_amdgcn_permlane16_swap(__float_as_uint(v), __float_as_uint(v), false, false); return fmaxf(__uint_as_float(r[0]), __uint_as_float(r[1])); }
__device__ __forceinline__ float xor32_max(float v) { const auto r = __builtin_amdgcn_permlane32_swap(__float_as_uint(v), __float_as_uint(v), false, false); return fmaxf(__uint_as_float(r[0]), __uint_as_float(r[1])); }
__device__ __forceinline__ float quad_sum(float v) { v += dpp_f<0xB1>(v); v += dpp_f<0x4E>(v); return v; }
__device__ __forceinline__ float wave_sum(float v) {
    v = quad_sum(v); v += dpp_f<0x141>(v); v += dpp_f<0x140>(v);
    return xor32_sum(xor16_sum(v));
}
__device__ __forceinline__ float wave_sum_lds(float v) {
#pragma unroll
    for (int o = 1; o < 64; o <<= 1) v += __shfl_xor(v, o);
    return v;
}
__device__ __forceinline__ float wave_sum_h(float v) {
    v = quad_sum(v); v += dpp_f<0x141>(v); v += dpp_f<0x140>(v);
    v += __shfl_xor(v, 16); v += __shfl_xor(v, 32);
    return v;
}
__device__ __forceinline__ float wave_max(float v) {
    v = fmaxf(v, dpp_f<0xB1>(v)); v = fmaxf(v, dpp_f<0x4E>(v)); v = fmaxf(v, dpp_f<0x141>(v)); v = fmaxf(v, dpp_f<0x140>(v));
    return xor32_max(xor16_max(v));
}

#define XB_TMO      128
#define XB_XCNT(j)  (256  + 64 * (j))
#define XB_XSUB(j)  (1280 + 64 * (j))
#define XB_XGEN(j)  (2304 + 64 * (j))
#define XB_TOP      3328
#define XB_TOPGEN   3392
#define XCD_BAR_WORDS 3456
#define XB_SPIN_CAP (1u << 18)
__device__ __forceinline__ unsigned xb_ld(unsigned* p)              { return __hip_atomic_load(p, __ATOMIC_RELAXED, __HIP_MEMORY_SCOPE_AGENT); }
__device__ __forceinline__ unsigned xb_add(unsigned* p, unsigned v) { return __hip_atomic_fetch_add(p, v, __ATOMIC_RELAXED, __HIP_MEMORY_SCOPE_AGENT); }
__device__ __forceinline__ unsigned xb_xcc_id() { return (unsigned)__builtin_amdgcn_s_getreg((3 << 11) | 20) & 0xFu; }
#define XB_SPIN(cond, bar) do { unsigned _sp = 0; while (cond) { __builtin_amdgcn_s_sleep(1); \
    if ((++_sp & 255u) == 0u) { if (xb_ld(&(bar)[XB_TMO])) break; if (_sp > XB_SPIN_CAP) { atomicAdd(&(bar)[XB_TMO], 1u); break; } } } } while (0)
struct XcdBarrier { unsigned* bar; unsigned x; volatile LAS unsigned* st; };
__device__ __forceinline__ XcdBarrier xcd_barrier_post(unsigned* bar, volatile LAS unsigned* st) {
    XcdBarrier b; b.bar = bar; b.x = xb_xcc_id(); b.st = st;
    if (threadIdx.x == 0) (void)xb_add(&bar[XB_XCNT(b.x)], 1u);
    return b;
}
__device__ __forceinline__ void xcd_barrier_complete(unsigned* bar, unsigned x, unsigned& nloc, unsigned& nx) {
    const unsigned G = gridDim.x * gridDim.y * gridDim.z;
    unsigned sum, cnt, mine, sp = 0u;
    for (;;) {
        sum = 0u; cnt = 0u; mine = 0u;
#pragma unroll
        for (unsigned j = 0; j < 16; ++j) { const unsigned c = xb_ld(&bar[XB_XCNT(j)]); sum += c; cnt += (c > 0u) ? 1u : 0u; mine = (j == x) ? c : mine; }
        if (sum == G) break;
        __builtin_amdgcn_s_sleep(1);
        if ((++sp & 255u) == 0u) { if (xb_ld(&bar[XB_TMO])) break; if (sp > XB_SPIN_CAP) { atomicAdd(&bar[XB_TMO], 1u); break; } }
    }
    nloc = mine > 0u ? mine : 1u; nx = cnt > 0u ? cnt : 1u;
}
__device__ __forceinline__ void xcd_barrier(const XcdBarrier& b) {
    asm volatile("s_waitcnt vmcnt(0)" ::: "memory");
    __syncthreads();
    if (threadIdx.x == 0) {
        unsigned* bar = b.bar;
        __builtin_amdgcn_s_waitcnt(0);
        unsigned nloc = b.st[0], nx = b.st[1];
        if (nloc == 0u) { xcd_barrier_complete(bar, b.x, nloc, nx); b.st[0] = nloc; b.st[1] = nx; }
        const unsigned old = xb_add(&bar[XB_XSUB(b.x)], 1u);
        const unsigned gen = old / nloc;
        if (old + 1u == (gen + 1u) * nloc) {
            __builtin_amdgcn_fence(__ATOMIC_RELEASE, "agent");
            asm volatile("s_waitcnt vmcnt(0)" ::: "memory");
            const unsigned og = xb_add(&bar[XB_TOP], 1u);
            const unsigned tg = og / nx;
            if (og + 1u == (tg + 1u) * nx) xb_add(&bar[XB_TOPGEN], 1u);
            else XB_SPIN(xb_ld(&bar[XB_TOPGEN]) == tg, bar);
            __builtin_amdgcn_fence(__ATOMIC_ACQUIRE, "agent");
            xb_add(&bar[XB_XGEN(b.x)], 1u);
            asm volatile("s_waitcnt vmcnt(0)" ::: "memory");
        } else {
            XB_SPIN(xb_ld(&bar[XB_XGEN(b.x)]) == gen, bar);
            __builtin_amdgcn_fence(__ATOMIC_ACQUIRE, "agent");
            asm volatile("s_waitcnt vmcnt(0)" ::: "memory");
        }
    }
    __syncthreads();
}

struct Args {
    const float *x, *w_in, *b_ig, *b_fg, *conv_w, *conv_b, *rel_bias, *beta_a, *beta_m, *w_out, *ln1_g, *ln1_b, *w_router, *b_router, *w_up, *b_up, *w_down, *b_down, *ln2_g, *ln2_b;
    float* out; unsigned char* ws; int ph_lo, ph_hi;
};
struct Frame {
    LAS unsigned char* lds;
    volatile LAS unsigned* MISC;
    gu32* ctl;
    int tid, lane, wave, vcu, G;
};

__device__ __forceinline__ void p0_transpose_item(const float* W, size_t ldw, bf16* WT, int K, int k0, int n0, int drow0, float scale, LAS float* scr, int lane) {
    float v[32];
#pragma unroll
    for (int i = 0; i < 32; ++i) { const int kk = 2 * i + (lane >> 5); v[i] = W[(size_t)(k0 + kk) * ldw + n0 + (lane & 31)]; }
#pragma unroll
    for (int i = 0; i < 32; ++i) { const int kk = 2 * i + (lane >> 5); scr[kk * 33 + (lane & 31)] = v[i] * scale; }
    LDS_WAIT(); asm volatile("" ::: "memory");
    const int c = lane & 7;
#pragma unroll
    for (int j = 0; j < 4; ++j) { const int n = (lane >> 3) + 8 * j; const LAS float* s = scr + (8 * c) * 33 + n;
        v4u o; o.x = pk2(s[0 * 33], s[1 * 33]); o.y = pk2(s[2 * 33], s[3 * 33]); o.z = pk2(s[4 * 33], s[5 * 33]); o.w = pk2(s[6 * 33], s[7 * 33]);
        *(GAS v4u*)(WT + (size_t)(drow0 + n) * K + k0 + 8 * c) = o; }
    LDS_WAIT(); asm volatile("" ::: "memory");
}
struct P0Item { const float* W; size_t ldw; unsigned char* WT; int k0, n0, drow0; float scale; };
__device__ __forceinline__ P0Item p0_item8(const Args& a, unsigned char* ws, int q) {
    constexpr int I_UP = 16 * 128, I_DN = 16 * 64; P0Item d;
    if (q < NEXP * I_UP) { const int e = q / I_UP, r = q % I_UP, kb = r / 128, nb = r % 128, n0 = 32 * nb, nn = n0 & 2047;
        d.W = a.w_up + (size_t)e * DM * 4096; d.ldw = 4096; d.WT = ws + WS_WUPT + (size_t)e * 4096 * LD8; d.k0 = 128 * kb; d.n0 = n0; d.drow0 = 256 * (nn >> 7) + (n0 >= 2048 ? 128 : 0) + (nn & 127); d.scale = 64.0f; }
    else { q -= NEXP * I_UP; const int e = q / I_DN, r = q % I_DN, kb = r / 64, nb = r % 64;
        d.W = a.w_down + (size_t)e * DM * DM; d.ldw = DM; d.WT = ws + WS_WDNT + (size_t)e * DM * LD8; d.k0 = 128 * kb; d.n0 = 32 * nb; d.drow0 = 32 * nb; d.scale = 128.0f; }
    return d;
}
__device__ __forceinline__ void p0_load8(const P0Item& d, float (&v)[64], int lane) {
#pragma unroll
    for (int i = 0; i < 64; ++i) { const int kk = 2 * i + (lane >> 5); v[i] = __builtin_nontemporal_load(d.W + (size_t)(d.k0 + kk) * d.ldw + d.n0 + (lane & 31)); }
}
__device__ __forceinline__ void p0_process8(const P0Item& d, const float (&v)[64], LAS float* scr, int lane) {
#pragma unroll
    for (int i = 0; i < 64; ++i) { const int kk = 2 * i + (lane >> 5); scr[kk * 33 + (lane & 31)] = v[i] * d.scale; }
    LDS_WAIT(); asm volatile("" ::: "memory");
    const int c = lane & 7;
#pragma unroll
    for (int j = 0; j < 4; ++j) { const int n = (lane >> 3) + 8 * j; const LAS float* s = scr + (16 * c) * 33 + n;
        v4u o; o.x = pg8::pk4_fp8(s[0 * 33], s[1 * 33], s[2 * 33], s[3 * 33]); o.y = pg8::pk4_fp8(s[4 * 33], s[5 * 33], s[6 * 33], s[7 * 33]);
        o.z = pg8::pk4_fp8(s[8 * 33], s[9 * 33], s[10 * 33], s[11 * 33]); o.w = pg8::pk4_fp8(s[12 * 33], s[13 * 33], s[14 * 33], s[15 * 33]);
        __builtin_nontemporal_store(o, (GAS v4u*)(d.WT + (size_t)(d.drow0 + n) * LD8 + d.k0 + 16 * c)); }
    LDS_WAIT(); asm volatile("" ::: "memory");
}
__device__ __forceinline__ void p0_prologue(Frame& F, const Args& a) {
    unsigned char* ws = a.ws;
    LAS float* scr = (LAS float*)(F.lds + RING_OFF + F.wave * 17408);
    const int gw = F.vcu * NWAVES + F.wave, NGW = F.G * NWAVES;
    constexpr int I_IN = 32 * 224, I_OUT = 32 * 64, I_UP = 16 * 128, I_DN = 16 * 64;
    for (int it = gw; it < I_IN + I_OUT; it += NGW) {
        int r = it;
        if (r < I_IN) { const int kb = r / 224, nb = r % 224; p0_transpose_item(a.w_in, INCOLS, (bf16*)(ws + WS_WINT), LDX, 64 * kb, 32 * nb, 32 * nb, (32 * nb < 1024) ? 0.125f * 1.4426950408889634f : 1.0f, scr, F.lane); continue; } r -= I_IN;
        { const int kb = r / 64, nb = r % 64; p0_transpose_item(a.w_out, DM, (bf16*)(ws + WS_WOUTT), LDX, 64 * kb, 32 * nb, 32 * nb, 1.0f, scr, F.lane); }
    }
    __syncthreads();
    LAS float* wgt = (LAS float*)(F.lds + RING_OFF);
    for (int i = F.tid; i < DM * 8; i += NWAVES * 64) { const int c = i >> 3, gq = i & 7; wgt[gq * DM + c] = a.w_in[(size_t)c * INCOLS + NPROJ + gq]; }
    __syncthreads();
    bf16* xb = (bf16*)(ws + WS_XB); float* gates = (float*)(ws + WS_GATES);
    for (int m = gw; m < NTOK; m += NGW) {
        const GAS f32x4* xr = (const GAS f32x4*)(a.x + (size_t)m * DM) + F.lane;
        f32x4 v[8];
#pragma unroll
        for (int j = 0; j < 8; ++j) v[j] = xr[64 * j];
        GAS v2u* o8 = (GAS v2u*)(xb + (size_t)m * LDX) + F.lane;
#pragma unroll
        for (int j = 0; j < 8; ++j) { v2u w; w.x = pk2(v[j].x, v[j].y); w.y = pk2(v[j].z, v[j].w); o8[64 * j] = w; }
        float mine = 0.f;
#pragma unroll 1
        for (int gq = 0; gq < 8; ++gq) { float s = 0.f;
#pragma unroll
            for (int j = 0; j < 8; ++j) { const f32x4 w = *(const LAS f32x4*)(wgt + gq * DM + 256 * j + 4 * F.lane); s += v[j].x * w.x + v[j].y * w.y + v[j].z * w.z + v[j].w * w.w; }
            s = wave_sum(s); if (F.lane == gq) mine = s; }
        if (F.lane < 8) gates[(size_t)m * 8 + F.lane] = mine + (F.lane < 4 ? a.b_ig[F.lane] : a.b_fg[F.lane - 4]);
    }
    { bf16* wrp = (bf16*)(ws + WS_WRT);
      for (int i = gw * 64 + F.lane; i < DM * NEXP; i += NGW * 64) { const int c = i >> 5, e = i & 31; const float f = a.w_router[i] * a.ln1_g[c];
          const unsigned u1 = pk2(f, 0.f) & 0xffffu; const unsigned u2 = pk2(f - bflo(u1), 0.f) & 0xffffu;
          wrp[(size_t)e * DM + c] = (bf16)u1; wrp[(size_t)NEXP * DM + (size_t)e * DM + c] = (bf16)u2; } }
    float* bt = (float*)(ws + WS_BIAS);
    for (int i = gw * 64 + F.lane; i < 3 * 16 * 132; i += NGW * 64) {
        const int j = i % 132, h = (i / 132) % 16, gq = i / (132 * 16); const int dist = j * (gq == 0 ? 1 : (gq == 1 ? 4 : 16));
        int bucket;
        if (dist < 16) bucket = dist;
        else { const float df = (float)dist; int lg = 16 + (int)(logf(df / 16.0f) / 4.852030263919617f * 16.0f); bucket = lg < 31 ? lg : 31; }
        bt[i] = a.rel_bias[bucket * 16 + h] * 1.4426950408889634f;
    }
    __syncthreads();
}

__device__ __forceinline__ void p1_router_consts(Frame& F, const Args& a) {
    unsigned char* ws = a.ws;
    __syncthreads();
    LAS float* red = (LAS float*)(F.lds + RING_OFF);
    const int e = F.tid & 31, part = F.tid >> 5; float s1 = 0.f, s2 = 0.f;
#pragma unroll 16
    for (int k = part * 128; k < part * 128 + 128; ++k) { const float wv = a.w_router[(size_t)k * NEXP + e]; s1 += a.ln1_g[k] * wv; s2 += a.ln1_b[k] * wv; }
    red[part * 32 + e] = s1; red[512 + part * 32 + e] = s2;
    __syncthreads();
    if (F.tid < 32) { float t1 = 0.f, t2 = 0.f; for (int p = 0; p < 16; ++p) { t1 += red[p * 32 + F.tid]; t2 += red[512 + p * 32 + F.tid]; }
        float* rc = (float*)(ws + WS_RC); rc[F.tid] = t1; rc[32 + F.tid] = t2 + a.b_router[F.tid]; }
    __syncthreads();
}
struct ConvClaim { gu32* ctr; int cur, nxt, idx; };
__device__ __forceinline__ int conv_claim(gu32* ctr, int lane) { unsigned c = 0u; if (lane == 0) c = __hip_atomic_fetch_add((unsigned*)ctr, 1u, RLX_AGENT); return __builtin_amdgcn_readfirstlane((int)c); }
__device__ __forceinline__ int conv_next(ConvClaim& s, int lane) {
    constexpr int NCH = NEXP * (16 * 128 + 16 * 64) / 8;
    if (s.idx == 8) { s.cur = s.nxt; s.idx = 0; if (s.cur < NCH) s.nxt = conv_claim(s.ctr, lane); }
    if (s.cur >= NCH) return -1;
    return s.cur * 8 + s.idx++;
}
__device__ __forceinline__ void p1_convert_experts(Frame& F, const Args& a) {
    unsigned char* ws = a.ws;
    LAS float* scr = (LAS float*)(F.lds + RING_OFF + F.wave * 17408);
    ConvClaim s; s.ctr = F.ctl + CW_CONV; s.cur = conv_claim(s.ctr, F.lane); s.nxt = conv_claim(s.ctr, F.lane); s.idx = 0;
    float va[64], vb[64]; int q = conv_next(s, F.lane);
    if (q >= 0) { P0Item da = p0_item8(a, ws, q); p0_load8(da, va, F.lane);
        for (;;) {
            const int q2 = conv_next(s, F.lane); P0Item db = da; if (q2 >= 0) { db = p0_item8(a, ws, q2); p0_load8(db, vb, F.lane); }
            p0_process8(da, va, scr, F.lane);
            if (q2 < 0) break;
            const int q3 = conv_next(s, F.lane); if (q3 >= 0) { da = p0_item8(a, ws, q3); p0_load8(da, va, F.lane); }
            p0_process8(db, vb, scr, F.lane);
            if (q3 < 0) break;
        } }
    __syncthreads();
}

__device__ __forceinline__ void p2_conv(Frame& F, const Args& a) {
    const bf16* proj = (const bf16*)(a.ws + WS_PROJ); bf16* qkm = (bf16*)(a.ws + WS_QKM);
    const int cg = F.tid & 63, r0 = F.tid >> 6;
    for (int ch = F.vcu; ch < 512; ch += F.G) {
        const int bh = ch >> 6, c = ch & 63, b = bh >> 2, hh = bh & 3;
        const int c0 = (cg < 32 ? 0 : 1024) + hh * 256 + 8 * (cg & 31); const float sc = (c0 >= 1024) ? 0.0625f : 1.0f;
        f32x4 cw[4][2], cb[2];
#pragma unroll
        for (int i = 0; i < 4; ++i) { cw[i][0] = *(const f32x4*)(a.conv_w + (size_t)i * 2048 + c0); cw[i][1] = *(const f32x4*)(a.conv_w + (size_t)i * 2048 + c0 + 4); }
        cb[0] = *(const f32x4*)(a.conv_b + c0); cb[1] = *(const f32x4*)(a.conv_b + c0 + 4);
        for (int rr = r0; rr < 128; rr += 16) {
            const int ts[2] = {128 * c + rr, 128 * c + rr + 8};
            v4u pv[2][4];
#pragma unroll
            for (int r = 0; r < 2; ++r)
#pragma unroll
                for (int i = 0; i < 4; ++i) { const int dt = 3 - i; pv[r][i] = (ts[r] - dt >= 0) ? *(const GAS v4u*)(proj + (size_t)(b * SEQ + ts[r] - dt) * LDP + C_QM + c0) : (v4u){0u, 0u, 0u, 0u}; }
#pragma unroll
            for (int r = 0; r < 2; ++r) {
                f32x4 av[2] = {cb[0], cb[1]};
#pragma unroll
                for (int i = 0; i < 4; ++i) { const v4u p = pv[r][i];
                    av[0] = av[0] + (f32x4){bflo(p.x), bfhi(p.x), bflo(p.y), bfhi(p.y)} * cw[i][0]; av[1] = av[1] + (f32x4){bflo(p.z), bfhi(p.z), bflo(p.w), bfhi(p.w)} * cw[i][1]; }
                float accv[8];
#pragma unroll
                for (int h = 0; h < 2; ++h) { const f32x4 t = av[h] * -1.4426950408889634f; f32x4 d;
#pragma unroll
                    for (int j = 0; j < 4; ++j) d[j] = __builtin_amdgcn_exp2f(t[j]);
                    d = d + 1.0f; f32x4 sg;
#pragma unroll
                    for (int j = 0; j < 4; ++j) sg[j] = __builtin_amdgcn_rcpf(d[j]);
                    const f32x4 rr = av[h] * sg * sc;
#pragma unroll
                    for (int j = 0; j < 4; ++j) accv[4 * h + j] = rr[j]; }
                v4u o; o.x = pk2(accv[0], accv[1]); o.y = pk2(accv[2], accv[3]); o.z = pk2(accv[4], accv[5]); o.w = pk2(accv[6], accv[7]);
                *(GAS v4u*)(qkm + (size_t)(b * SEQ + ts[r]) * LDQ + c0) = o;
            }
        }
    }
    asm volatile("s_waitcnt vmcnt(0)" ::: "memory"); __syncthreads();
}


typedef short bf16x8_t __attribute__((ext_vector_type(8)));
typedef short s16x4_t __attribute__((ext_vector_type(4)));
constexpr int AT_PITCH = 160, AT_ROWS = 272, AT_K = 0, AT_V = AT_ROWS * AT_PITCH, AT_BIAS = 2 * AT_ROWS * AT_PITCH, AT_OST = AT_BIAS + 1024;
__device__ __forceinline__ s16x4_t lds_tr16(const LAS unsigned char* p) { return __builtin_bit_cast(s16x4_t, __builtin_amdgcn_ds_read_tr16_b64_v4i16((LAS s16x4_t*)p)); }
__device__ __forceinline__ bf16x8_t tr_frag(const LAS unsigned char* img, int pitch, int base_row, int col0, int lane) {
    const int i = lane & 15, g = lane >> 4, q = i >> 2, p = i & 3;
    const LAS unsigned char* a = img + (base_row + 4 * g + q) * pitch + (col0 + 4 * p) * 2;
    const s16x4_t lo = lds_tr16(a), hi = lds_tr16(a + 16 * pitch);
    return (bf16x8_t){lo[0], lo[1], lo[2], lo[3], hi[0], hi[1], hi[2], hi[3]};
}
struct AtUnit { int b, h, br, dil, r, n; };
__device__ __forceinline__ AtUnit at_decode(int u) {
    AtUnit t; const int bh = u / 192, rem = u % 192, blk = rem & 63; t.br = rem >> 6; t.b = bh >> 4; t.h = bh & 15;
    t.dil = t.br == 0 ? 1 : (t.br == 1 ? 4 : 16); const int nbk = 64 / t.dil; t.r = blk / nbk; t.n = blk % nbk; return t;
}
__device__ __forceinline__ void at_load(const AtUnit& t, const bf16* proj, const float* bt, int tid, int w, int qa, int g4, v4u (&kx)[4], v4u (&vx)[4], bf16x8_t (&qf)[2], float& bias) {
    const int piece = tid & 7;
#pragma unroll
    for (int i = 0; i < 4; ++i) { const int row = (tid >> 3) + 64 * i; const int m = 128 * (t.n - 1) + row;
        kx[i] = (v4u){0u, 0u, 0u, 0u}; vx[i] = (v4u){0u, 0u, 0u, 0u};
        if (m >= 0) { const bf16* rp = proj + (size_t)(t.b * SEQ + t.r + t.dil * m) * LDP + t.h * 64 + piece * 8; kx[i] = *(const GAS v4u*)(rp + C_KA); vx[i] = *(const GAS v4u*)(rp + C_VA); } }
    const size_t qrow = (size_t)(t.b * SEQ + t.r + t.dil * (128 * t.n + 16 * w + qa));
#pragma unroll
    for (int s = 0; s < 2; ++s) qf[s] = *(const GAS bf16x8_t*)(proj + qrow * LDP + C_QA + t.h * 64 + 32 * s + 8 * g4);
    bias = (tid < 132) ? bt[(t.br * 16 + t.h) * 132 + tid] : 0.f;
}
__device__ __forceinline__ void p3_attn_mfma(Frame& F, const Args& a) {
    const bf16* proj = (const bf16*)(a.ws + WS_PROJ); const float* bt = (const float*)(a.ws + WS_BIAS);
    bf16* og = (bf16*)(a.ws + WS_OG); float* lseo = (float*)(a.ws + WS_LSE);
    LAS unsigned char* L = F.lds + RING_OFF;
    const int w = F.wave; constexpr int NU = BATCH * NHA * 192;
    v4u kx[4], vx[4]; bf16x8_t qn[2]; float biasn;
    if (F.vcu < NU) { const AtUnit t0 = at_decode(F.vcu); at_load(t0, proj, bt, F.tid, w, F.lane & 15, F.lane >> 4, kx, vx, qn, biasn); }
    for (int u = F.vcu; u < NU; u += F.G) {
        int tid = F.tid; asm volatile("" : "+v"(tid));
        const int lane = tid & 63, qa = lane & 15, g4 = lane >> 4;
        const AtUnit t = at_decode(u); const int b = t.b, h = t.h, br = t.br, dil = t.dil, r = t.r, n = t.n;
        {
            const int piece = tid & 7;
#pragma unroll
            for (int i = 0; i < 4; ++i) { const int row = (tid >> 3) + 64 * i; *(LAS v4u*)(L + AT_K + row * AT_PITCH + piece * 16) = kx[i]; *(LAS v4u*)(L + AT_V + row * AT_PITCH + piece * 16) = vx[i]; }
            if (tid < 160) { *(LAS v4u*)(L + AT_K + 256 * AT_PITCH + tid * 16) = (v4u){0u, 0u, 0u, 0u}; *(LAS v4u*)(L + AT_V + 256 * AT_PITCH + tid * 16) = (v4u){0u, 0u, 0u, 0u}; }
            if (tid < 132) ((LAS float*)(L + AT_BIAS))[tid] = biasn;
        }
        bf16x8_t qf[2]; qf[0] = qn[0]; qf[1] = qn[1];
        const size_t qrow = (size_t)(b * SEQ + r + dil * (128 * n + 16 * w + qa));
        __syncthreads();
        if (u + F.G < NU) { const AtUnit tn = at_decode(u + F.G); at_load(tn, proj, bt, tid, w, qa, g4, kx, vx, qn, biasn); }
        f32x4 sc[10];
        const LAS float* bl = (const LAS float*)(L + AT_BIAS);
        { const int jb = 128 + qa - 4 * g4;
          const LAS float* blw = bl + (jb - 115);
#pragma unroll
          for (int rg = 0; rg < 4; ++rg) { const int j0 = jb - rg, j8 = jb - 128 - rg; sc[0][rg] = bl[j0 < 128 ? j0 : 128]; sc[8][rg] = bl[j8 > 0 ? j8 : 0]; }
#pragma unroll
          for (int kb = 1; kb < 8; ++kb)
#pragma unroll
              for (int rg = 0; rg < 4; ++rg) sc[kb][rg] = blw[16 * (7 - kb) + (3 - rg)];
          const LAS unsigned char* kbase = L + AT_K + (16 * w + qa) * AT_PITCH + 16 * g4;
#pragma unroll
          for (int hb = 0; hb < 9; hb += 3) { bf16x8_t k0[3], k1[3];
#pragma unroll
              for (int i = 0; i < 3; ++i) { k0[i] = *(const LAS bf16x8_t*)(kbase + (hb + i) * 16 * AT_PITCH); k1[i] = *(const LAS bf16x8_t*)(kbase + (hb + i) * 16 * AT_PITCH + 64); }
#pragma unroll
              for (int i = 0; i < 3; ++i) { const f32x4 sv = __builtin_amdgcn_mfma_f32_16x16x32_bf16(k0[i], qf[0], sc[hb + i], 0, 0, 0);
                  sc[hb + i] = __builtin_amdgcn_mfma_f32_16x16x32_bf16(k1[i], qf[1], sv, 0, 0, 0); } }
          const bool npos = n > 0;
#pragma unroll
          for (int rg = 0; rg < 4; ++rg) { const int c = 4 * g4 + rg;
              sc[0][rg] = (npos && qa <= c) ? sc[0][rg] : -1e30f;
              sc[8][rg] = (qa >= c) ? sc[8][rg] : -1e30f; }
          if (!npos) {
#pragma unroll
              for (int kb = 1; kb < 8; ++kb) { const bool okb = (w + kb >= 8);
#pragma unroll
                  for (int rg = 0; rg < 4; ++rg) sc[kb][rg] = okb ? sc[kb][rg] : -1e30f; } } }
        float mx = -1e30f;
#pragma unroll
        for (int kb = 0; kb < 9; ++kb) mx = fmaxf(mx, fmaxf(fmaxf(sc[kb][0], sc[kb][1]), fmaxf(sc[kb][2], sc[kb][3])));
        mx = xor32_max(xor16_max(mx));
        float den = 0.f;
#pragma unroll
        for (int kb = 0; kb < 9; ++kb)
#pragma unroll
            for (int rg = 0; rg < 4; ++rg) { const float p = __builtin_amdgcn_exp2f(sc[kb][rg] - mx); sc[kb][rg] = p; den += p; }
        sc[9] = (f32x4){0.f, 0.f, 0.f, 0.f};
        den = xor32_sum(xor16_sum(den));
        f32x4 o[4];
#pragma unroll
        for (int c = 0; c < 4; ++c) o[c] = (f32x4){0.f, 0.f, 0.f, 0.f};
#pragma unroll
        for (int pp = 0; pp < 5; ++pp) {
            unsigned pw[4]; pw[0] = pk2(sc[2 * pp][0], sc[2 * pp][1]); pw[1] = pk2(sc[2 * pp][2], sc[2 * pp][3]); pw[2] = pk2(sc[2 * pp + 1][0], sc[2 * pp + 1][1]); pw[3] = pk2(sc[2 * pp + 1][2], sc[2 * pp + 1][3]);
            const bf16x8_t pf = __builtin_bit_cast(bf16x8_t, (v4u){pw[0], pw[1], pw[2], pw[3]});
#pragma unroll
            for (int c = 0; c < 4; ++c) { const bf16x8_t vf = tr_frag(L + AT_V, AT_PITCH, 16 * (w + 2 * pp), 16 * c, lane); o[c] = __builtin_amdgcn_mfma_f32_16x16x32_bf16(pf, vf, o[c], 0, 0, 0); }
        }
        { LAS float* P = (LAS float*)(L + AT_OST + w * (16 * 68 * 4));
#pragma unroll
          for (int c = 0; c < 4; ++c)
#pragma unroll
              for (int rg = 0; rg < 4; ++rg) P[(4 * g4 + rg) * 68 + 16 * c + qa] = o[c][rg];
          const float inv = 1.0f / den;
          bf16* op = og + ((size_t)br * NTOK + qrow) * LDOG + h * 64;
#pragma unroll
          for (int i = 0; i < 2; ++i) { const int pc = g4 + 4 * i; const f32x4 v0 = *(const LAS f32x4*)(P + qa * 68 + 8 * pc), v1 = *(const LAS f32x4*)(P + qa * 68 + 8 * pc + 4);
              v4u ow; ow.x = pk2(v0[0] * inv, v0[1] * inv); ow.y = pk2(v0[2] * inv, v0[3] * inv); ow.z = pk2(v1[0] * inv, v1[1] * inv); ow.w = pk2(v1[2] * inv, v1[3] * inv);
              *(GAS v4u*)(op + 8 * pc) = ow; } }
        if (g4 == 0) lseo[((size_t)br * NTOK + qrow) * 16 + h] = (mx + __log2f(den)) * 0.6931471805599453f;
        __syncthreads();
    }
}
__device__ __forceinline__ void p4_attn_combine(Frame& F, const Args& a) {
    const bf16* og = (const bf16*)(a.ws + WS_OG); const float* lse = (const float*)(a.ws + WS_LSE); bf16* yb = (bf16*)(a.ws + WS_Y);
    const int gw = F.vcu * NWAVES + F.wave, NGW = F.G * NWAVES, lane = F.lane, h = lane >> 2;
    f32x4 be[4];
#pragma unroll
    for (int i = 0; i < 4; ++i) be[i] = *(const f32x4*)(a.beta_a + lane * 16 + 4 * i);
    for (int m0 = gw; m0 < NTOK; m0 += 2 * NGW) {
        const int mr[2] = {m0, (m0 + NGW < NTOK) ? m0 + NGW : m0};
        float ls[2][3]; v4u pv[2][3][2];
#pragma unroll
        for (int r = 0; r < 2; ++r)
#pragma unroll
            for (int br = 0; br < 3; ++br) { ls[r][br] = lse[((size_t)br * NTOK + mr[r]) * 16 + h]; const GAS v4u* p = (const GAS v4u*)(og + ((size_t)br * NTOK + mr[r]) * LDOG + lane * 16); pv[r][br][0] = p[0]; pv[r][br][1] = p[1]; }
#pragma unroll
        for (int r = 0; r < 2; ++r) {
            const float l0 = ls[r][0], l1 = ls[r][1], l2 = ls[r][2];
            const float M = fmaxf(fmaxf(l0, l1), l2); float w0 = __expf(l0 - M), w1 = __expf(l1 - M), w2 = __expf(l2 - M); const float iw = 1.0f / (w0 + w1 + w2); w0 *= iw; w1 *= iw; w2 *= iw;
            float o[16];
#pragma unroll
            for (int j = 0; j < 16; ++j) o[j] = 0.f;
#pragma unroll
            for (int br = 0; br < 3; ++br) { const float wg = br == 0 ? w0 : (br == 1 ? w1 : w2);
#pragma unroll
                for (int c = 0; c < 2; ++c) { const v4u v = pv[r][br][c]; o[8 * c] += wg * bflo(v.x); o[8 * c + 1] += wg * bfhi(v.x); o[8 * c + 2] += wg * bflo(v.y); o[8 * c + 3] += wg * bfhi(v.y); o[8 * c + 4] += wg * bflo(v.z); o[8 * c + 5] += wg * bfhi(v.z); o[8 * c + 6] += wg * bflo(v.w); o[8 * c + 7] += wg * bfhi(v.w); } }
            float ss = 0.f;
#pragma unroll
            for (int j = 0; j < 16; ++j) ss += o[j] * o[j];
            ss = quad_sum(ss);
            const float rs = rsqrtf(ss * (1.0f / 64.0f) + HN_EPS);
            v4u w0v, w1v;
            w0v.x = pk2(o[0] * rs * be[0].x, o[1] * rs * be[0].y); w0v.y = pk2(o[2] * rs * be[0].z, o[3] * rs * be[0].w); w0v.z = pk2(o[4] * rs * be[1].x, o[5] * rs * be[1].y); w0v.w = pk2(o[6] * rs * be[1].z, o[7] * rs * be[1].w);
            w1v.x = pk2(o[8] * rs * be[2].x, o[9] * rs * be[2].y); w1v.y = pk2(o[10] * rs * be[2].z, o[11] * rs * be[2].w); w1v.z = pk2(o[12] * rs * be[3].x, o[13] * rs * be[3].y); w1v.w = pk2(o[14] * rs * be[3].z, o[15] * rs * be[3].w);
            if (r == 0 || mr[1] != mr[0]) { GAS v4u* yo = (GAS v4u*)(yb + (size_t)mr[r] * LDY + lane * 16); yo[0] = w0v; yo[1] = w1v; }
        }
    }
}


constexpr int ML_PITCH = 544, ML_IMG = 128 * ML_PITCH, ML_K = 0, ML_V = ML_IMG, ML_SM = 2 * ML_IMG;
constexpr int SM_B = 0, SM_U = 128, SM_MR = 256, SM_WS = 384, SM_NL = 512;
__device__ __forceinline__ float wave_incl_sum(float v, int lane) {
#pragma unroll
    for (int o = 1; o < 64; o <<= 1) { const float t = __shfl_up(v, o); if (lane >= o) v += t; }
    return v;
}
__device__ __forceinline__ float wave_incl_max(float v, int lane) {
#pragma unroll
    for (int o = 1; o < 64; o <<= 1) { const float t = __shfl_up(v, o); if (lane >= o) v = fmaxf(v, t); }
    return v;
}
__device__ __forceinline__ void ml_load128(v4u (&r)[8], const bf16* src, size_t ld, int tid) {
    const int piece = tid & 31;
#pragma unroll
    for (int i = 0; i < 8; ++i) { const int row = (tid >> 5) + 16 * i; r[i] = *(const GAS v4u*)(src + (size_t)row * ld + piece * 8); }
}
__device__ __forceinline__ void ml_store128(LAS unsigned char* img, const v4u (&r)[8], int tid, const LAS float* rowscale) {
    const int piece = tid & 31;
#pragma unroll
    for (int i = 0; i < 8; ++i) { const int row = (tid >> 5) + 16 * i; v4u v = r[i];
        if (rowscale) { const float s = rowscale[row];
            v.x = pk2(bflo(v.x) * s, bfhi(v.x) * s); v.y = pk2(bflo(v.y) * s, bfhi(v.y) * s); v.z = pk2(bflo(v.z) * s, bfhi(v.z) * s); v.w = pk2(bflo(v.w) * s, bfhi(v.w) * s); }
        *(LAS v4u*)(img + row * ML_PITCH + piece * 16) = v; }
}
__device__ __forceinline__ void p3_mlstm_local(Frame& F, const Args& a) {
    const bf16* proj = (const bf16*)(a.ws + WS_PROJ); const bf16* qkm = (const bf16*)(a.ws + WS_QKM); const float* gates = (const float*)(a.ws + WS_GATES);
    bf16* cloc = (bf16*)(a.ws + WS_CLOC); float* bcum = (float*)(a.ws + WS_BCUM); float* ucol = (float*)(a.ws + WS_UCOL); float* chs = (float*)(a.ws + WS_CHS); float* nloc = (float*)(a.ws + WS_NLOC);
    LAS unsigned char* L = F.lds + RING_OFF; LAS float* sm = (LAS float*)(L + ML_SM);
    const int w = F.wave;
    v4u kx[8], vx[8]; float ig0 = 0.f, fg0 = 0.f, ig1 = 0.f, fg1 = 0.f;
    auto issue = [&](int chn, int tidn) {
        const int bhn = chn >> 6, cn = chn & 63, bn = bhn >> 2, hn = bhn & 3; const size_t rown = (size_t)bn * SEQ + 128 * cn;
        ml_load128(kx, qkm + rown * LDQ + 1024 + hn * 256, LDQ, tidn); ml_load128(vx, proj + rown * LDP + C_VM + hn * 256, LDP, tidn);
        if (w == 0) { const int s0n = 2 * (tidn & 63);
            ig0 = gates[(rown + s0n) * 8 + hn]; fg0 = gates[(rown + s0n) * 8 + 4 + hn]; ig1 = gates[(rown + s0n + 1) * 8 + hn]; fg1 = gates[(rown + s0n + 1) * 8 + 4 + hn]; } };
    if (F.vcu < 512) issue(F.vcu, F.tid);
    for (int ch = F.vcu; ch < 512; ch += F.G) {
        int tid = F.tid; asm volatile("" : "+v"(tid));
        const int lane = tid & 63, qa = lane & 15, g4 = lane >> 4;
        const int bh = ch >> 6, c = ch & 63, b = bh >> 2, hh = bh & 3; const size_t row0 = (size_t)b * SEQ + 128 * c;
        if (w == 0) {
            const int s0 = 2 * lane;
            const float lf0 = fminf(fg0, 0.f) - log1pf(expf(-fabsf(fg0))), lf1 = fminf(fg1, 0.f) - log1pf(expf(-fabsf(fg1)));
            const float incl = wave_incl_sum(lf0 + lf1, lane), b1 = incl, b0 = incl - lf1, gsum = __shfl(incl, 63);
            const float u0 = ig0 - b0, u1 = ig1 - b1, umax = wave_max(fmaxf(u0, u1));
            sm[SM_B + s0] = b0; sm[SM_B + s0 + 1] = b1; sm[SM_U + s0] = u0; sm[SM_U + s0 + 1] = u1; sm[SM_WS + s0] = expf(u0 - umax); sm[SM_WS + s0 + 1] = expf(u1 - umax);
            bcum[(size_t)ch * 128 + s0] = b0; bcum[(size_t)ch * 128 + s0 + 1] = b1; ucol[(size_t)ch * 128 + s0] = u0; ucol[(size_t)ch * 128 + s0 + 1] = u1;
            if (lane == 0) { chs[ch] = gsum; chs[512 + ch] = gsum + umax; }
        }
        ml_store128(L + ML_K, kx, tid, nullptr);
        __syncthreads();
        ml_store128(L + ML_V, vx, tid, sm + SM_WS);
        __syncthreads();
        if (ch + F.G < 512) issue(ch + F.G, tid);
        if (tid < 256) { float acc = 0.f;
            for (int s = 0; s < 128; ++s) acc += sm[SM_WS + s] * bf1(*(const LAS bf16*)(L + ML_K + s * ML_PITCH + tid * 2));
            nloc[(size_t)ch * 256 + tid] = acc; }
        f32x4 acc[2][16];
#pragma unroll
        for (int i = 0; i < 2; ++i)
#pragma unroll
            for (int cb = 0; cb < 16; ++cb) acc[i][cb] = (f32x4){0.f, 0.f, 0.f, 0.f};
#pragma unroll 1
        for (int ks = 0; ks < 4; ++ks) {
            const bf16x8_t a0 = tr_frag(L + ML_V, ML_PITCH, 32 * ks, 16 * (2 * w), lane), a1 = tr_frag(L + ML_V, ML_PITCH, 32 * ks, 16 * (2 * w + 1), lane);
#pragma unroll
            for (int cb = 0; cb < 16; ++cb) { const bf16x8_t kf = tr_frag(L + ML_K, ML_PITCH, 32 * ks, 16 * cb, lane);
                acc[0][cb] = __builtin_amdgcn_mfma_f32_16x16x32_bf16(a0, kf, acc[0][cb], 0, 0, 0); acc[1][cb] = __builtin_amdgcn_mfma_f32_16x16x32_bf16(a1, kf, acc[1][cb], 0, 0, 0); }
        }
        bf16* ct = cloc + (size_t)ch * 65536 + 16 * (2 * w + (g4 & 1)) + 8 * (g4 >> 1);
#pragma unroll
        for (int cb = 0; cb < 16; ++cb) {
            const auto rx = __builtin_amdgcn_permlane16_swap(pk2(acc[0][cb][0], acc[0][cb][1]), pk2(acc[1][cb][0], acc[1][cb][1]), false, false);
            const auto ry = __builtin_amdgcn_permlane16_swap(pk2(acc[0][cb][2], acc[0][cb][3]), pk2(acc[1][cb][2], acc[1][cb][3]), false, false);
            *(GAS v4u*)(ct + (size_t)(16 * cb + qa) * 256) = (v4u){rx[0], ry[0], rx[1], ry[1]}; }
        __syncthreads();
    }
}
__device__ __forceinline__ void p4_mlstm_scan(Frame& F, const Args& a) {
    const bf16* cloc = (const bf16*)(a.ws + WS_CLOC); bf16* cprev = (bf16*)(a.ws + WS_CPREV); float* chs = (float*)(a.ws + WS_CHS);
    const float* nloc = (const float*)(a.ws + WS_NLOC); float* nprev = (float*)(a.ws + WS_NPREV);
    LAS float* AB = (LAS float*)(F.lds + RING_OFF);
    for (int it0 = F.vcu * 512; it0 < 8 * 16384; it0 += F.G * 512) {
        const int bh = it0 >> 14, e4 = (it0 & 16383) + F.tid;
        __syncthreads();
        if (F.tid < 64) {
            const int c = F.tid; const float gc = chs[bh * 64 + c], mlc = chs[512 + bh * 64 + c];
            const float G = wave_incl_sum(gc, c); const float pm = wave_incl_max(mlc - G, c); const float mc = G + fmaxf(0.f, pm);
            float mp = __shfl_up(mc, 1); if (c == 0) mp = 0.f;
            AB[c] = expf(gc + mp - mc); AB[64 + c] = expf(mlc - mc);
            if ((it0 & 16383) == 0) chs[1024 + bh * 64 + c] = mp;
        }
        __syncthreads();
        float s0 = 0.f, s1 = 0.f, s2 = 0.f, s3 = 0.f;
        const bf16* src = cloc + (size_t)bh * 64 * 65536 + e4 * 4; bf16* dst = cprev + (size_t)bh * 64 * 65536 + e4 * 4;
#pragma unroll 1
        for (int c0 = 0; c0 < 64; c0 += 32) {
            v2u x[32];
#pragma unroll
            for (int i = 0; i < 32; ++i) x[i] = __builtin_nontemporal_load((const GAS v2u*)(src + (size_t)(c0 + i) * 65536));
#pragma unroll
            for (int i = 0; i < 32; ++i) { const int c = c0 + i;
                v2u o; o.x = pk2(s0, s1); o.y = pk2(s2, s3); *(GAS v2u*)(dst + (size_t)c * 65536) = o;
                const float A = AB[c], B = AB[64 + c];
                s0 = A * s0 + B * bflo(x[i].x); s1 = A * s1 + B * bfhi(x[i].x); s2 = A * s2 + B * bflo(x[i].y); s3 = A * s3 + B * bfhi(x[i].y); }
        }
        if ((it0 & 16383) == 0 && F.tid < 256) {
            const int dk = F.tid; float s = 0.f;
            float nl[64];
#pragma unroll
            for (int c = 0; c < 64; ++c) nl[c] = nloc[(size_t)(bh * 64 + c) * 256 + dk];
#pragma unroll
            for (int c = 0; c < 64; ++c) { nprev[(size_t)(bh * 64 + c) * 256 + dk] = s; s = AB[c] * s + AB[64 + c] * nl[c]; }
        }
    }
    __syncthreads();
}
template <int MODE> __device__ __forceinline__ void p5_mlstm_out(Frame& F, const Args& a) {
    const bf16* proj = (const bf16*)(a.ws + WS_PROJ); const bf16* qkm = (const bf16*)(a.ws + WS_QKM); const bf16* cprev = (const bf16*)(a.ws + WS_CPREV);
    const float* bcum = (const float*)(a.ws + WS_BCUM); const float* ucol = (const float*)(a.ws + WS_UCOL); const float* chs = (const float*)(a.ws + WS_CHS); const float* nprev = (const float*)(a.ws + WS_NPREV);
    bf16* yb = (bf16*)(a.ws + WS_Y);
    LAS unsigned char* L = F.lds + RING_OFF; LAS float* sm = (LAS float*)(L + ML_SM);
    const int w = F.wave;
    for (int ch = F.vcu; ch < 512; ch += F.G) {
        int tid = F.tid; asm volatile("" : "+v"(tid));
        const int lane = tid & 63, qa = lane & 15, g4 = lane >> 4;
        const int bh = ch >> 6, c = ch & 63, b = bh >> 2, hh = bh & 3; const size_t row0 = (size_t)b * SEQ + 128 * c;
        const float mprev = chs[1024 + ch];
        v4u kx[8], vx[8];
        ml_load128(kx, qkm + row0 * LDQ + 1024 + hh * 256, LDQ, tid); ml_load128(vx, proj + row0 * LDP + C_VM + hh * 256, LDP, tid);
        const size_t trow = row0 + 16 * w + qa;
        bf16x8_t qf[8];
#pragma unroll
        for (int ks = 0; ks < 8; ++ks) { const bf16* qp = qkm + trow * LDQ + hh * 256 + 32 * ks + 4 * g4; const v2u lo = *(const GAS v2u*)qp, hi = *(const GAS v2u*)(qp + 16);
            qf[ks] = __builtin_bit_cast(bf16x8_t, (v4u){lo.x, lo.y, hi.x, hi.y}); }
        if (w == 0) {
            const int s0 = 2 * lane;
            const float b0 = bcum[(size_t)ch * 128 + s0], b1 = bcum[(size_t)ch * 128 + s0 + 1], u0 = ucol[(size_t)ch * 128 + s0], u1 = ucol[(size_t)ch * 128 + s0 + 1];
            const float incl = wave_incl_max(fmaxf(u0, u1), lane); float excl = __shfl_up(incl, 1); if (lane == 0) excl = -3.0e38f;
            sm[SM_B + s0] = b0; sm[SM_B + s0 + 1] = b1; sm[SM_U + s0] = u0; sm[SM_U + s0 + 1] = u1;
            sm[SM_MR + s0] = fmaxf(mprev, fmaxf(excl, u0)); sm[SM_MR + s0 + 1] = fmaxf(mprev, incl);
        } else if (w <= 4) { const int dk = (w - 1) * 64 + lane; sm[SM_NL + dk] = nprev[(size_t)ch * 256 + dk]; }
        ml_store128(L + ML_K, kx, tid, nullptr); ml_store128(L + ML_V, vx, tid, nullptr);
        __syncthreads();
        if (MODE == 1) { asm volatile("" :: "v"(qf[0]), "v"(qf[7])); __syncthreads(); continue; }
        const float Mt = sm[SM_MR + 16 * w + qa], bt_ = sm[SM_B + 16 * w + qa];
        f32x4 sc[8]; float rsum = 0.f;
#pragma unroll
        for (int sb = 0; sb < 8; ++sb) {
            f32x4 s = (f32x4){0.f, 0.f, 0.f, 0.f};
            if (sb <= w) {
#pragma unroll
                for (int ks = 0; ks < 8; ++ks) { const LAS unsigned char* kp = L + ML_K + (16 * sb + qa) * ML_PITCH + (32 * ks + 4 * g4) * 2;
                    const v2u lo = *(const LAS v2u*)kp, hi = *(const LAS v2u*)(kp + 32);
                    s = __builtin_amdgcn_mfma_f32_16x16x32_bf16(__builtin_bit_cast(bf16x8_t, (v4u){lo.x, lo.y, hi.x, hi.y}), qf[ks], s, 0, 0, 0); }
                const f32x4 uv = *(const LAS f32x4*)(sm + SM_U + 16 * sb + 4 * g4);
#pragma unroll
                for (int rg = 0; rg < 4; ++rg) { const bool ok = (16 * sb + 4 * g4 + rg) <= 16 * w + qa;
                    const float wv = ok ? __expf(uv[rg] - Mt) * s[rg] : 0.f; s[rg] = wv; rsum += wv; }
            }
            sc[sb] = s;
        }
        rsum = xor32_sum(xor16_sum(rsum));
        float nq = 0.f;
#pragma unroll
        for (int ks = 0; ks < 8; ++ks) { const f32x4 n0 = *(const LAS f32x4*)(sm + SM_NL + 32 * ks + 4 * g4), n1 = *(const LAS f32x4*)(sm + SM_NL + 32 * ks + 16 + 4 * g4);
            const v4u qw = __builtin_bit_cast(v4u, qf[ks]);
            nq += n0.x * bflo(qw.x) + n0.y * bfhi(qw.x) + n0.z * bflo(qw.y) + n0.w * bfhi(qw.y) + n1.x * bflo(qw.z) + n1.y * bfhi(qw.z) + n1.z * bflo(qw.w) + n1.w * bfhi(qw.w); }
        nq = xor32_sum(xor16_sum(nq));
        const float decay = expf(mprev - Mt), den = rsum + decay * nq, scale = 1.0f / fmaxf(fabsf(den), expf(-(bt_ + Mt)));
#pragma unroll
        for (int ks = 0; ks < 8; ++ks) { v4u qw = __builtin_bit_cast(v4u, qf[ks]);
            qw.x = pk2(bflo(qw.x) * decay, bfhi(qw.x) * decay); qw.y = pk2(bflo(qw.y) * decay, bfhi(qw.y) * decay); qw.z = pk2(bflo(qw.z) * decay, bfhi(qw.z) * decay); qw.w = pk2(bflo(qw.w) * decay, bfhi(qw.w) * decay);
            qf[ks] = __builtin_bit_cast(bf16x8_t, qw); }
        if (MODE == 2) { _Pragma("unroll") for (int i_ = 0; i_ < 8; ++i_) asm volatile("" :: "v"(sc[i_]), "v"(qf[i_])); asm volatile("" :: "v"(scale)); __syncthreads(); continue; }
        bf16x8_t pf[4];
#pragma unroll
        for (int pp = 0; pp < 4; ++pp) pf[pp] = __builtin_bit_cast(bf16x8_t, (v4u){pk2(sc[2 * pp][0], sc[2 * pp][1]), pk2(sc[2 * pp][2], sc[2 * pp][3]), pk2(sc[2 * pp + 1][0], sc[2 * pp + 1][1]), pk2(sc[2 * pp + 1][2], sc[2 * pp + 1][3])});
        v4u cpre[12];
        { const bf16* cp = cprev + (size_t)ch * 65536; const int piece = tid & 31;
#pragma unroll
          for (int i = 0; i < 12; ++i) { const int row = (tid >> 5) + 16 * i; cpre[i] = *(const GAS v4u*)(cp + (size_t)row * 256 + piece * 8); } }
        f32x4 o[16];
#pragma unroll
        for (int cb = 0; cb < 16; ++cb) o[cb] = (f32x4){0.f, 0.f, 0.f, 0.f};
#pragma unroll
        for (int pp = 0; pp < 4; ++pp) {
            if (2 * pp <= w) {
#pragma unroll
                for (int cb = 0; cb < 16; ++cb) { const bf16x8_t vf = tr_frag(L + ML_V, ML_PITCH, 32 * pp, 16 * cb, lane); o[cb] = __builtin_amdgcn_mfma_f32_16x16x32_bf16(pf[pp], vf, o[cb], 0, 0, 0); }
            }
        }
        if (MODE == 3) { _Pragma("unroll") for (int cb_ = 0; cb_ < 16; ++cb_) asm volatile("" :: "v"(o[cb_])); _Pragma("unroll") for (int i_ = 0; i_ < 12; ++i_) asm volatile("" :: "v"(cpre[i_])); __syncthreads(); continue; }
        __syncthreads();
        { const bf16* cp = cprev + (size_t)ch * 65536; const int piece = tid & 31; v4u late[4];
#pragma unroll
          for (int i = 0; i < 4; ++i) { const int row = (tid >> 5) + 16 * (12 + i); late[i] = *(const GAS v4u*)(cp + (size_t)row * 256 + piece * 8); }
#pragma unroll
          for (int i = 0; i < 12; ++i) { const int row = (tid >> 5) + 16 * i; *(LAS v4u*)(L + row * ML_PITCH + piece * 16) = cpre[i]; }
#pragma unroll
          for (int i = 0; i < 4; ++i) { const int row = (tid >> 5) + 16 * (12 + i); *(LAS v4u*)(L + row * ML_PITCH + piece * 16) = late[i]; } }
        __syncthreads();
#pragma unroll
        for (int ks = 0; ks < 8; ++ks) {
#pragma unroll
            for (int cb = 0; cb < 16; ++cb) { const bf16x8_t cf = tr_frag(L, ML_PITCH, 32 * ks, 16 * cb, lane); o[cb] = __builtin_amdgcn_mfma_f32_16x16x32_bf16(qf[ks], cf, o[cb], 0, 0, 0); }
        }
        if (MODE == 4) { _Pragma("unroll") for (int cb_ = 0; cb_ < 16; ++cb_) asm volatile("" :: "v"(o[cb_])); asm volatile("" :: "v"(scale)); __syncthreads(); continue; }
        __syncthreads();
        { LAS float* P = (LAS float*)(L + w * (16 * 260 * 4));
#pragma unroll
          for (int cb = 0; cb < 16; ++cb)
#pragma unroll
              for (int rg = 0; rg < 4; ++rg) P[(4 * g4 + rg) * 260 + 16 * cb + qa] = o[cb][rg];
          const size_t orow = row0 + 16 * w + qa; const int dv0 = 64 * g4;
          const GAS v4u* omp = (const GAS v4u*)(proj + orow * LDP + C_OM + hh * 256 + dv0);
          v4u omw[8];
#pragma unroll
          for (int i = 0; i < 8; ++i) omw[i] = omp[i];
          f32x4 val[16]; float ss = 0.f;
#pragma unroll
          for (int i = 0; i < 16; ++i) val[i] = *(const LAS f32x4*)(P + qa * 260 + dv0 + 4 * i);
          f32x4 ss4 = (f32x4){0.f, 0.f, 0.f, 0.f};
#pragma unroll
          for (int i = 0; i < 8; ++i) { const unsigned ww[4] = {omw[i].x, omw[i].y, omw[i].z, omw[i].w};
#pragma unroll
              for (int q = 0; q < 2; ++q) { const f32x4 om = (f32x4){bflo(ww[2 * q]), bfhi(ww[2 * q]), bflo(ww[2 * q + 1]), bfhi(ww[2 * q + 1])}; const f32x4 t = om * -1.4426950408889634f; f32x4 d;
#pragma unroll
                  for (int j = 0; j < 4; ++j) d[j] = __builtin_amdgcn_exp2f(t[j]);
                  d = d + 1.0f; f32x4 sg;
#pragma unroll
                  for (int j = 0; j < 4; ++j) sg[j] = __builtin_amdgcn_rcpf(d[j]);
                  const f32x4 av = val[2 * i + q] * scale * sg; val[2 * i + q] = av; ss4 = ss4 + av * av; } }
          ss += (ss4[0] + ss4[1]) + (ss4[2] + ss4[3]);
          ss = xor32_sum(xor16_sum(ss));
          const float rs = rsqrtf(ss * (1.0f / 256.0f) + HN_EPS);
          const f32x4* bmp = (const f32x4*)(a.beta_m + hh * 256 + dv0);
          LAS unsigned char* Pb = (LAS unsigned char*)P;
#pragma unroll
          for (int i = 0; i < 8; ++i) { const f32x4 b0 = bmp[2 * i], b1 = bmp[2 * i + 1]; const f32x4 v0 = val[2 * i] * rs * b0, v1 = val[2 * i + 1] * rs * b1;
              v4u ow; ow.x = pk2(v0[0], v0[1]); ow.y = pk2(v0[2], v0[3]); ow.z = pk2(v1[0], v1[1]); ow.w = pk2(v1[2], v1[3]); *(LAS v4u*)(Pb + qa * 528 + 128 * g4 + 16 * i) = ow; }
#pragma unroll
          for (int i = 0; i < 8; ++i) { const int r = 2 * i + (lane >> 5), pc = lane & 31; const v4u ow = *(const LAS v4u*)(Pb + r * 528 + 16 * pc);
              *(GAS v4u*)(yb + (row0 + 16 * w + r) * LDY + 1024 + hh * 256 + 8 * pc) = ow; }
        }
        __syncthreads();
    }
}

__device__ __forceinline__ void p7_ln_router(Frame& F, const Args& a) {
    const bf16* z = (const bf16*)(a.ws + WS_Z); unsigned char* hb = a.ws + WS_HB; const float* rc = (const float*)(a.ws + WS_RC);
    unsigned* list = (unsigned*)(a.ws + WS_LIST); unsigned* tokinfo = (unsigned*)(a.ws + WS_TOKINFO);
    LAS float* lg = (LAS float*)(F.lds + RING_OFF);
    LAS unsigned* lcnt = (LAS unsigned*)(F.lds + RING_OFF + 16384); LAS unsigned* gbase = lcnt + 32;
    LAS float* st = (LAS float*)(F.lds + RING_OFF + 12288);
    const int lane = F.lane, w = F.wave;
    if (F.tid < 32) lcnt[F.tid] = 0u;
    LAS float* lnv = (LAS float*)(F.lds + RING_OFF + 32768);
    { const f32x4 t0 = ((const f32x4*)a.ln1_g)[F.tid], t1 = ((const f32x4*)a.ln1_b)[F.tid]; ((LAS f32x4*)lnv)[F.tid] = t0; ((LAS f32x4*)(lnv + DM))[F.tid] = t1; }
    __syncthreads();
    for (int grp = F.vcu; grp < NTOK / 64; grp += F.G) {
        const int base = grp * 64;
        for (int i = 0; i < 8; i += 2) {
            f32x4 v[2][8]; float s[2] = {0.f, 0.f};
#pragma unroll
            for (int r = 0; r < 2; ++r) { const GAS v2u* zr = (const GAS v2u*)(z + (size_t)(base + 8 * w + i + r) * LDX) + lane;
#pragma unroll
                for (int j = 0; j < 8; ++j) { const v2u zw = zr[64 * j]; v[r][j] = (f32x4){bflo(zw.x), bfhi(zw.x), bflo(zw.y), bfhi(zw.y)}; } }
#pragma unroll
            for (int r = 0; r < 2; ++r)
#pragma unroll
                for (int j = 0; j < 8; ++j) s[r] += (v[r][j].x + v[r][j].y) + (v[r][j].z + v[r][j].w);
            const float mean[2] = {wave_sum(s[0]) * (1.f / DM), wave_sum(s[1]) * (1.f / DM)}; float s2[2] = {0.f, 0.f};
#pragma unroll
            for (int r = 0; r < 2; ++r)
#pragma unroll
                for (int j = 0; j < 8; ++j) { v[r][j] = v[r][j] - mean[r]; s2[r] += (v[r][j].x * v[r][j].x + v[r][j].y * v[r][j].y) + (v[r][j].z * v[r][j].z + v[r][j].w * v[r][j].w); }
            const float rstd[2] = {rsqrtf(wave_sum(s2[0]) * (1.f / DM) + LN_EPS), rsqrtf(wave_sum(s2[1]) * (1.f / DM) + LN_EPS)};
            if (lane == 0) { *(LAS f32x4*)(st + 2 * (8 * w + i)) = (f32x4){mean[0], rstd[0], mean[1], rstd[1]}; }
#pragma unroll
            for (int j = 0; j < 8; ++j) { const f32x4 gg = *(const LAS f32x4*)(lnv + 256 * j + 4 * lane), bb = *(const LAS f32x4*)(lnv + DM + 256 * j + 4 * lane);
#pragma unroll
                for (int r = 0; r < 2; ++r) { const f32x4 hv = v[r][j] * rstd[r] * gg + bb;
                    ((GAS unsigned*)(hb + (size_t)(base + 8 * w + i + r) * LD8) + lane)[64 * j] = pg8::pk4_fp8(hv.x * 16.f, hv.y * 16.f, hv.z * 16.f, hv.w * 16.f); } }
        }
        __syncthreads();
        {
            const int qa = lane & 15, kq = lane >> 4;
            const bf16* wp = (const bf16*)(a.ws + WS_WRT) + (size_t)qa * DM + 256 * w + 8 * kq;
            bf16x8_t wf[2][2][8];
#pragma unroll
            for (int p = 0; p < 2; ++p)
#pragma unroll
                for (int eh = 0; eh < 2; ++eh)
#pragma unroll
                    for (int ks = 0; ks < 8; ++ks) wf[p][eh][ks] = *(const GAS bf16x8_t*)(wp + (size_t)p * NEXP * DM + (size_t)eh * 16 * DM + 32 * ks);
            LAS float* part = (LAS float*)(F.lds + RING_OFF + 49152);
#pragma unroll 1
            for (int rp = 0; rp < 4; ++rp) {
                constexpr int QB = 1;
                bf16x8_t zf[QB][8];
#pragma unroll
                for (int q = 0; q < QB; ++q)
#pragma unroll
                    for (int ks = 0; ks < 8; ++ks) zf[q][ks] = *(const GAS bf16x8_t*)(z + (size_t)(base + 16 * QB * rp + 16 * q + qa) * LDX + 256 * w + 32 * ks + 8 * kq);
#pragma unroll
                for (int q = 0; q < QB; ++q) {
                    f32x4 a0 = (f32x4){0.f, 0.f, 0.f, 0.f}, a1 = a0, c0 = a0, c1 = a0;
#pragma unroll
                    for (int ks = 0; ks < 8; ++ks) { a0 = __builtin_amdgcn_mfma_f32_16x16x32_bf16(zf[q][ks], wf[0][0][ks], a0, 0, 0, 0); a1 = __builtin_amdgcn_mfma_f32_16x16x32_bf16(zf[q][ks], wf[0][1][ks], a1, 0, 0, 0);
                        c0 = __builtin_amdgcn_mfma_f32_16x16x32_bf16(zf[q][ks], wf[1][0][ks], c0, 0, 0, 0); c1 = __builtin_amdgcn_mfma_f32_16x16x32_bf16(zf[q][ks], wf[1][1][ks], c1, 0, 0, 0); }
                    a0 = a0 + c0; a1 = a1 + c1;
#pragma unroll
                    for (int rg = 0; rg < 4; ++rg) { const int row = 16 * QB * rp + 16 * q + 4 * kq + rg; part[(w * 64 + row) * 33 + qa] = a0[rg]; part[(w * 64 + row) * 33 + 16 + qa] = a1[rg]; }
                }
            }
        }
        __syncthreads();
        {
            const int row = F.tid >> 3, e0 = (F.tid & 7) * 4; const float mu = st[2 * row], rs = st[2 * row + 1];
            const LAS float* part = (const LAS float*)(F.lds + RING_OFF + 49152);
#pragma unroll
            for (int j = 0; j < 4; ++j) { float sacc = 0.f;
#pragma unroll
                for (int ww = 0; ww < 8; ++ww) sacc += part[(ww * 64 + row) * 33 + e0 + j];
                lg[row * 33 + e0 + j] = rs * (sacc - mu * rc[e0 + j]) + rc[32 + e0 + j]; }
        }
        __syncthreads();
        int sel[4] = {0, 0, 0, 0}; unsigned lp[4] = {0u, 0u, 0u, 0u}; float gt[4] = {0.f, 0.f, 0.f, 0.f};
        if (w < 4) {
            if (lane < 16) {
                const LAS float* lr = lg + (w * 16 + lane) * 33;
                float sv[4];
#pragma unroll
                for (int k = 0; k < 4; ++k) { float best = -3.0e38f; int bi = 0;
                    for (int e = 0; e < 32; ++e) { const float x = lr[e]; const bool taken = (k > 0 && sel[0] == e) || (k > 1 && sel[1] == e) || (k > 2 && sel[2] == e); if (!taken && x > best) { best = x; bi = e; } }
                    sel[k] = bi; sv[k] = best; }
                const float e1 = __expf(sv[1] - sv[0]), e2 = __expf(sv[2] - sv[0]), e3 = __expf(sv[3] - sv[0]); const float inv = 1.0f / (1.0f + e1 + e2 + e3);
                gt[0] = inv; gt[1] = e1 * inv; gt[2] = e2 * inv; gt[3] = e3 * inv;
#pragma unroll
                for (int k = 0; k < 4; ++k) lp[k] = __hip_atomic_fetch_add(lcnt + sel[k], 1u, __ATOMIC_RELAXED, __HIP_MEMORY_SCOPE_WORKGROUP);
            }
        }
        __syncthreads();
        if (F.tid < 32) { const unsigned c = lcnt[F.tid]; gbase[F.tid] = c ? __hip_atomic_fetch_add((unsigned*)(F.ctl + CW_CNT + 64 * F.tid), c, RLX_AGENT) : 0u; lcnt[F.tid] = 0u; }
        __syncthreads();
        if (w < 4 && lane < 16) { const int m = base + 16 * w + lane;
#pragma unroll
            for (int k = 0; k < 4; ++k) { const unsigned pos = gbase[sel[k]] + lp[k]; list[(size_t)sel[k] * CAP + pos] = (unsigned)m;
                tokinfo[(size_t)m * 8 + 2 * k] = ((unsigned)sel[k] << 16) | pos; tokinfo[(size_t)m * 8 + 2 * k + 1] = __float_as_uint(gt[k]); } }
        __syncthreads();
    }
}

template <bool GATHER_> struct MoeOrder {
    static constexpr bool GATHER = GATHER_;
    const LAS int* tab; const unsigned* list; int NT, G, c, total;
    __device__ __forceinline__ bool next(int i, pg8::Unit& u) const {
        const int L = i * G + c; if (L >= total) return false;
        const int ln = (int)__builtin_amdgcn_mbcnt_hi(~0u, __builtin_amdgcn_mbcnt_lo(~0u, 0u));
        const int tk = tab[ln & 31];
        const int e = __builtin_popcountll(__ballot(ln >= 1 && ln < 32 && L >= tk * NT));
        const int t0 = __builtin_amdgcn_readfirstlane(tab[e]), nte = __builtin_amdgcn_readfirstlane(tab[e + 1]) - t0, q = L - t0 * NT, per = nte * 4, grp = q / per, rem = q - grp * per, ml = rem >> 2;
        u.pm = t0 + ml; u.pn = grp * 4 + (rem & 3); u.e = e; u.aux = ml * 256; return true;
    }
    __device__ __forceinline__ int btile(const pg8::Unit& u) const { return u.e * NT + u.pn; }
    __device__ __forceinline__ unsigned arow(const pg8::Unit& u, int r) const {
        const int pos = u.aux + r; const int cnt = tab[33 + u.e]; const int pc = pos < cnt ? pos : cnt - 1;
        const unsigned tok = list[(size_t)u.e * CAP + pc];
        return (pos < cnt ? tok : 0u) * (unsigned)LD8;
    }
};
__device__ __forceinline__ void moe_tab(Frame& F) {
    LAS int* tab = (LAS int*)(F.lds + TAB_OFF);
    if (F.tid < 32) tab[33 + F.tid] = (int)__hip_atomic_load((unsigned*)(F.ctl + CW_CNT + 64 * F.tid), RLX_AGENT);
    __syncthreads();
    if (F.tid == 0) { int s = 0; for (int e = 0; e < 32; ++e) { tab[e] = s; int c = tab[33 + e]; if (c > CAP) c = CAP; s += (c + 255) >> 8; } if (s > MAXTILES) s = MAXTILES; tab[32] = s; }
    __syncthreads();
}

__device__ __forceinline__ void p9_final(Frame& F, const Args& a) {
    const bf16* z = (const bf16*)(a.ws + WS_Z); const unsigned char* ys = a.ws + WS_YS; const unsigned* tokinfo = (const unsigned*)(a.ws + WS_TOKINFO);
    const LAS int* tab = (const LAS int*)(F.lds + TAB_OFF);
    const int gw = F.vcu * NWAVES + F.wave, NGW = F.G * NWAVES, lane = F.lane;
    LAS float* lnv = (LAS float*)(F.lds + RING_OFF);
    { const f32x4 t2 = ((const f32x4*)a.ln2_g)[F.tid], t3 = ((const f32x4*)a.ln2_b)[F.tid]; ((LAS f32x4*)lnv)[F.tid] = t2; ((LAS f32x4*)(lnv + DM))[F.tid] = t3; }
    __syncthreads();
    for (int m0 = gw; m0 < NTOK; m0 += 2 * NGW) {
        const int mr[2] = {m0, (m0 + NGW < NTOK) ? m0 + NGW : m0};
        unsigned ti[2][8]; f32x4 v[2][8]; v2u zq[2][8]; unsigned yw[2][4][8]; float g16[2][4];
#pragma unroll
        for (int r = 0; r < 2; ++r) {
#pragma unroll
            for (int k = 0; k < 8; ++k) ti[r][k] = tokinfo[(size_t)mr[r] * 8 + k];
            const GAS v2u* zr = (const GAS v2u*)(z + (size_t)mr[r] * LDX) + lane;
#pragma unroll
            for (int j = 0; j < 8; ++j) zq[r][j] = zr[64 * j]; }
#pragma unroll
        for (int r = 0; r < 2; ++r)
#pragma unroll
            for (int k = 0; k < 4; ++k) { const unsigned ep = ti[r][2 * k]; g16[r][k] = __uint_as_float(ti[r][2 * k + 1]) * 0.0625f;
                const int e = (int)(ep >> 16), pos = (int)(ep & 0xffffu); const size_t slot = (size_t)tab[e] * 256 + pos;
                const GAS unsigned* yr = (const GAS unsigned*)(ys + slot * LD8) + lane;
#pragma unroll
                for (int j = 0; j < 8; ++j) yw[r][k][j] = yr[64 * j]; }
#pragma unroll
        for (int r = 0; r < 2; ++r) {
            {
                float s = 0.f;
#pragma unroll
                for (int j = 0; j < 8; ++j) { const v2u zw = zq[r][j]; v[r][j] = (f32x4){bflo(zw.x), bfhi(zw.x), bflo(zw.y), bfhi(zw.y)}; s += (v[r][j].x + v[r][j].y) + (v[r][j].z + v[r][j].w); }
                const float mean = wave_sum_h(s) * (1.f / DM); float s2 = 0.f;
#pragma unroll
                for (int j = 0; j < 8; ++j) { v[r][j] = v[r][j] - mean; s2 += (v[r][j].x * v[r][j].x + v[r][j].y * v[r][j].y) + (v[r][j].z * v[r][j].z + v[r][j].w * v[r][j].w); }
                const float rstd = rsqrtf(wave_sum_h(s2) * (1.f / DM) + LN_EPS);
#pragma unroll
                for (int j = 0; j < 8; ++j) { const f32x4 gg = *(const f32x4*)(a.ln1_g + 256 * j + 4 * lane), bb = *(const f32x4*)(a.ln1_b + 256 * j + 4 * lane); v[r][j] = (v[r][j] * rstd * gg + bb) * DN_ALPHA; }
            }
#pragma unroll
            for (int k = 0; k < 4; ++k)
#pragma unroll
                for (int j = 0; j < 8; ++j) { const unsigned w = yw[r][k][j]; const f32x2_ lo = __builtin_amdgcn_cvt_pk_f32_fp8(w, false), hi = __builtin_amdgcn_cvt_pk_f32_fp8(w, true); const float gq = g16[r][k];
                    v[r][j] = v[r][j] + (f32x4){lo.x, lo.y, hi.x, hi.y} * gq; }
            float s = 0.f;
#pragma unroll
            for (int j = 0; j < 8; ++j) s += (v[r][j].x + v[r][j].y) + (v[r][j].z + v[r][j].w);
            const float mean = wave_sum_h(s) * (1.f / DM); float s2 = 0.f;
#pragma unroll
            for (int j = 0; j < 8; ++j) { v[r][j] = v[r][j] - mean; s2 += (v[r][j].x * v[r][j].x + v[r][j].y * v[r][j].y) + (v[r][j].z * v[r][j].z + v[r][j].w * v[r][j].w); }
            const float rstd = rsqrtf(wave_sum_h(s2) * (1.f / DM) + LN_EPS);
            if (r == 0 || mr[1] != mr[0]) { GAS f32x4* o = (GAS f32x4*)(a.out + (size_t)mr[r] * DM) + lane;
#pragma unroll
                for (int j = 0; j < 8; ++j) { const f32x4 gg = *(const LAS f32x4*)(lnv + 256 * j + 4 * lane), bb = *(const LAS f32x4*)(lnv + DM + 256 * j + 4 * lane); o[64 * j] = v[r][j] * rstd * gg + bb; } }
        }
    }
}

__global__ void __launch_bounds__(NWAVES * 64, 2) hymba_fwd(Args args) {
    extern __shared__ __attribute__((aligned(16))) unsigned char lds[];
    Frame F;
    F.lds = (LAS unsigned char*)lds;
    F.MISC = (volatile LAS unsigned*)(F.lds + MISC_OFF);
    F.tid = threadIdx.x; F.lane = F.tid & 63; F.wave = __builtin_amdgcn_readfirstlane(F.tid >> 6);
    F.G = gridDim.x; { const int bx = blockIdx.x; F.vcu = (F.G % 8 == 0) ? (bx % 8) * (F.G / 8) + bx / 8 : bx; }
    F.ctl = (gu32*)(args.ws + WS_CTL);
    for (int u = F.tid; u < (LDS_BYTES - LDSCTL_OFF) / 4; u += NWAVES * 64) ((LAS unsigned*)(F.lds + LDSCTL_OFF))[u] = 0u;
    __syncthreads();
#if MK_ONE_LAUNCH
    XcdBarrier bar = xcd_barrier_post((unsigned*)(F.ctl + CW_BAR), F.MISC + 8);
#define GRID_BAR() xcd_barrier(bar)
#else
#define GRID_BAR() do { } while (0)
#endif
    const int lo = args.ph_lo, hi = args.ph_hi;
#define IN(k) (lo <= (k) && (k) < hi)
#define BOTH(k) (IN(k) && IN((k) + 1))
    unsigned char* ws = args.ws;

    if (IN(0)) for (int rep_ = 0; rep_ <= ((REP_MASK >> 0) & 1); ++rep_) { p0_prologue(F, args); if (BOTH(0) && rep_ == ((REP_MASK >> 0) & 1)) GRID_BAR(); }

    if (IN(1)) for (int rep_ = 0; rep_ <= ((REP_MASK >> 1) & 1); ++rep_) {
        const bool split = (F.G % 8 == 0) && (F.G >= 64);
        const int xg = (int)blockIdx.x & 7, xr = (int)blockIdx.x >> 3, per = F.G >> 3;
        {
            pg8::Gemm g{ws + WS_XB, ws + WS_WINT, DM * 2, LDX * 2, LDX * 2}; pg8::StaticOrder S;
            if (split) {
                constexpr int NG = 8 - XCONV;
                const int nblk = (NTOK / pg8::BM) * (NPROJ / pg8::BM) / per, nfull = (nblk / NG) * NG, left = nblk - nfull, give = (left <= XCONV && nblk * per == (NTOK / pg8::BM) * (NPROJ / pg8::BM)) ? left : 0;
                if (xg >= XCONV) { S.init(NTOK, NPROJ, per * NG, xr * NG + (xg - XCONV), NG); S.il = 1; S.lim = give ? nfull * per : S.nwg; }
                else { const int lb = XCONV - 1 - xg; S.init(NTOK, NPROJ, per, xr, 1); S.il = 1; S.base = (nfull + lb) * per; S.lim = lb < give ? S.base + per : 0; }
            } else S.init(NTOK, NPROJ, F.G, (int)blockIdx.x);
            pg8::EpiBf16Plain E{(bf16*)(ws + WS_PROJ), LDP};
            pg8::gemm_phase<pg8::EpiBf16Plain, pg8::StaticOrder>(F.lds + RING_OFF, g, S, E);
        }
        if (blockIdx.x == 0) p1_router_consts(F, args);
        p1_convert_experts(F, args);
        if (BOTH(1) && rep_ == ((REP_MASK >> 1) & 1)) GRID_BAR();
    }
    if (IN(2)) for (int rep_ = 0; rep_ <= ((REP_MASK >> 2) & 1); ++rep_) { p2_conv(F, args);   }
    if (IN(3)) for (int rep_ = 0; rep_ <= ((REP_MASK >> 3) & 1); ++rep_) { p3_mlstm_local(F, args); p3_attn_mfma(F, args); if (BOTH(3) && rep_ == ((REP_MASK >> 3) & 1)) GRID_BAR(); }
    if (IN(4)) for (int rep_ = 0; rep_ <= ((REP_MASK >> 4) & 1); ++rep_) {   p4_attn_combine(F, args); p4_mlstm_scan(F, args); if (BOTH(4) && rep_ == ((REP_MASK >> 4) & 1)) GRID_BAR(); }
    if (IN(5)) for (int rep_ = 0; rep_ <= ((REP_MASK >> 5) & 1); ++rep_) { p5_mlstm_out<0>(F, args);
#ifdef P5_PROBE_MODE
        p5_mlstm_out<P5_PROBE_MODE>(F, args);
#endif
        if (BOTH(5) && rep_ == ((REP_MASK >> 5) & 1)) GRID_BAR(); }
    if (IN(6)) for (int rep_ = 0; rep_ <= ((REP_MASK >> 6) & 1); ++rep_) {
        pg8::Gemm g{ws + WS_Y, ws + WS_WOUTT, DM * 2, LDY * 2, LDX * 2}; pg8::StaticOrder S; S.init(NTOK, DM, F.G, (int)blockIdx.x);
        if (F.G % 8 == 0 && (NTOK / pg8::BM) * (DM / pg8::BM) % (F.G / 8) == 0) S.il = 1;
        pg8::EpiF32Res E{(bf16*)(ws + WS_Z), args.x, LDX, DM, DN_ALPHA};
        pg8::gemm_phase<pg8::EpiF32Res, pg8::StaticOrder>(F.lds + RING_OFF, g, S, E);
        if (BOTH(6) && rep_ == ((REP_MASK >> 6) & 1)) GRID_BAR();
    }
    if (IN(7)) for (int rep_ = 0; rep_ <= ((REP_MASK >> 7) & 1); ++rep_) { p7_ln_router(F, args); if (BOTH(7) && rep_ == ((REP_MASK >> 7) & 1)) GRID_BAR(); }
    if (IN(8)) for (int rep_ = 0; rep_ <= ((REP_MASK >> 8) & 1); ++rep_) {
        moe_tab(F);
        const LAS int* tab = (const LAS int*)(F.lds + TAB_OFF);
        MoeOrder<true> S{tab, (const unsigned*)(ws + WS_LIST), 16, F.G, F.vcu, __builtin_amdgcn_readfirstlane(tab[32]) * 16};
        pg8::Gemm g{ws + WS_HB, ws + WS_WUPT, DM, LD8, LD8};
        pg8::EpiSwiglu E{ws + WS_ACT, args.b_up, 4.0f, LD8};
        pg8::gemm_phase<pg8::EpiSwiglu, MoeOrder<true>, true, 0x7B7B7B7B, 0x79797979>(F.lds + RING_OFF, g, S, E);
        if (BOTH(8) && rep_ == ((REP_MASK >> 8) & 1)) GRID_BAR();
    }
    if (IN(9)) for (int rep_ = 0; rep_ <= ((REP_MASK >> 9) & 1); ++rep_) {
        moe_tab(F);
        const LAS int* tab = (const LAS int*)(F.lds + TAB_OFF);
        MoeOrder<false> S{tab, nullptr, 8, F.G, F.vcu, __builtin_amdgcn_readfirstlane(tab[32]) * 8};
        pg8::Gemm g{ws + WS_ACT, ws + WS_WDNT, DM, LD8, LD8};
        pg8::EpiBf16Bias E{ws + WS_YS, args.b_down, LD8};
        pg8::gemm_phase<pg8::EpiBf16Bias, MoeOrder<false>, true, 0x7D7D7D7D, 0x78787878>(F.lds + RING_OFF, g, S, E);
        if (BOTH(9) && rep_ == ((REP_MASK >> 9) & 1)) GRID_BAR();
    }
    if (IN(10)) for (int rep_ = 0; rep_ <= ((REP_MASK >> 10) & 1); ++rep_) { moe_tab(F); p9_final(F, args); }
#undef IN
#undef BOTH
}

extern "C" void kernel_launch(void* const* d_in, const int* in_sizes, int n_in, void* d_out, int out_size, void* d_ws, size_t ws_size, hipStream_t stream) {
    static int grid = 0;
    if (grid == 0) {
        if (n_in != 20 || in_sizes[0] != NTOK * DM || out_size != NTOK * DM || ws_size < WS_END) { fprintf(stderr, "kernel_launch: unexpected shapes (n_in %d, in0 %d, out %d, ws %zu < %zu); nothing launched\n", n_in, n_in > 0 ? in_sizes[0] : -1, out_size, ws_size, (size_t)WS_END); grid = -1; return; }
        int dev = 0, cus = 0, per_cu = 0;
        if (hipGetDevice(&dev) != hipSuccess || hipDeviceGetAttribute(&cus, hipDeviceAttributeMultiprocessorCount, dev) != hipSuccess) { grid = -1; return; }
        if (hipFuncSetAttribute((const void*)hymba_fwd, hipFuncAttributeMaxDynamicSharedMemorySize, LDS_BYTES) != hipSuccess) { fprintf(stderr, "kernel_launch: hipFuncSetAttribute failed\n"); grid = -1; return; }
        if (hipOccupancyMaxActiveBlocksPerMultiprocessor(&per_cu, (const void*)hymba_fwd, NWAVES * 64, LDS_BYTES) != hipSuccess || per_cu < 1)
            fprintf(stderr, "kernel_launch: note: occupancy query reports %d workgroups per CU\n", per_cu);
        (void)hipGetLastError();
        grid = cus;
    }
    if (grid < 0) return;
    if (hipMemsetAsync((char*)d_ws + WS_CTL, 0, CTL_ZERO_BYTES, stream) != hipSuccess) return;
    Args a{};
    a.x = (const float*)d_in[0]; a.w_in = (const float*)d_in[1]; a.b_ig = (const float*)d_in[2]; a.b_fg = (const float*)d_in[3]; a.conv_w = (const float*)d_in[4]; a.conv_b = (const float*)d_in[5];
    a.rel_bias = (const float*)d_in[6]; a.beta_a = (const float*)d_in[7]; a.beta_m = (const float*)d_in[8]; a.w_out = (const float*)d_in[9]; a.ln1_g = (const float*)d_in[10]; a.ln1_b = (const float*)d_in[11];
    a.w_router = (const float*)d_in[12]; a.b_router = (const float*)d_in[13]; a.w_up = (const float*)d_in[14]; a.b_up = (const float*)d_in[15]; a.w_down = (const float*)d_in[16]; a.b_down = (const float*)d_in[17];
    a.ln2_g = (const float*)d_in[18]; a.ln2_b = (const float*)d_in[19];
    a.out = (float*)d_out; a.ws = (unsigned char*)d_ws;
#if MK_ONE_LAUNCH
    a.ph_lo = 0; a.ph_hi = NPHASE;
    hipLaunchKernelGGL(hymba_fwd, dim3(grid), dim3(NWAVES * 64), LDS_BYTES, stream, a);
#else
    for (int p = 0; p < NPHASE; ++p) { a.ph_lo = p; a.ph_hi = p + 1; hipLaunchKernelGGL(hymba_fwd, dim3(grid), dim3(NWAVES * 64), LDS_BYTES, stream, a); }
#endif
}
```
